# Optimizing an MI355X kernel written in HIP

```python
import jax, jax.numpy as jnp
from jax import lax
import numpy as np

D_MODEL = 1024
BATCH = 2
SEQ = 8192
DEPTH = 2
DEC_BATCH = 32
DEC_SEQ = 2048
PAST_LEN = 128

GRID_W = 64
N_MEM = 256
D_MIX = 2 * D_MODEL
GROUP_W = D_MIX // 4
HEAD_DIM = 64
N_HEADS = GROUP_W // HEAD_DIM
N_KV_HEADS = 2
Q_PER_KV = N_HEADS // N_KV_HEADS
ROPE_PAIRS = HEAD_DIM // 4
ROPE_THETA = 10000.0
Q_BLOCK = 128
N_FOURIER_GROUPS = 4
FOURIER_W = GROUP_W // N_FOURIER_GROUPS
N_SGU_HEADS = 4
SGU_W = GROUP_W // N_SGU_HEADS
CHUNK = 128
N_MEM_HEADS = 4
MEM_HEAD_DIM = GROUP_W // N_MEM_HEADS
EPS = 1e-6
SPLIT_SIZES = (GROUP_W, N_KV_HEADS * HEAD_DIM, N_KV_HEADS * HEAD_DIM, GROUP_W,
               GROUP_W, GROUP_W, GROUP_W, GROUP_W, GROUP_W, GROUP_W, GROUP_W)
IN_W = sum(SPLIT_SIZES)
SPLIT_POINTS = tuple(int(v) for v in np.cumsum(SPLIT_SIZES)[:-1])

kernel_name = "hybrid_parallel_group_encoder"


def rms_norm(x, g):
    xf = x.astype(jnp.float32)
    y = xf * lax.rsqrt(jnp.mean(xf * xf, axis=-1, keepdims=True) + EPS)
    return (y * g.astype(jnp.float32)).astype(x.dtype)


def axial_rope_tables(S):
    rows = S // GRID_W
    row = jnp.broadcast_to(jnp.arange(rows, dtype=jnp.float32)[:, None], (rows, GRID_W)).reshape(S)
    col = jnp.broadcast_to(jnp.arange(GRID_W, dtype=jnp.float32)[None, :], (rows, GRID_W)).reshape(S)
    inv = ROPE_THETA ** (-jnp.arange(ROPE_PAIRS, dtype=jnp.float32) / ROPE_PAIRS)
    ang = jnp.stack([row[:, None] * inv, col[:, None] * inv], axis=1)
    return jnp.cos(ang), jnp.sin(ang)


def apply_axial_rope(x, cos, sin):
    B, S, H, _ = x.shape
    xr = x.astype(jnp.float32).reshape(B, S, H, 2, 2, ROPE_PAIRS)
    x1, x2 = xr[..., 0, :], xr[..., 1, :]
    c = cos[None, :, None]
    s = sin[None, :, None]
    out = jnp.stack([x1 * c - x2 * s, x2 * c + x1 * s], axis=-2)
    return out.reshape(B, S, H, HEAD_DIM).astype(x.dtype)


def self_attention(q, k, v):
    B, S = q.shape[0], q.shape[1]
    nblk = S // Q_BLOCK
    scale = HEAD_DIM ** -0.5
    qb = q.reshape(B, nblk, Q_BLOCK, N_KV_HEADS, Q_PER_KV, HEAD_DIM).transpose(1, 0, 2, 3, 4, 5)

    def one_block(qblk):
        s = jnp.einsum('bqkgd,bskd->bkgqs', qblk, k, preferred_element_type=jnp.float32) * scale
        p = jax.nn.softmax(s, axis=-1)
        return jnp.einsum('bkgqs,bskd->bqkgd', p.astype(v.dtype), v)

    o = lax.map(one_block, qb)
    return o.transpose(1, 0, 2, 3, 4, 5).reshape(B, S, N_HEADS * HEAD_DIM)


def fourier_mix(a, w_f):
    B, S, _ = a.shape
    ag = a.astype(jnp.float32).reshape(B, S, N_FOURIER_GROUPS, FOURIER_W)
    f = jnp.fft.fft2(ag, axes=(1, 3), norm='ortho').real
    y = jnp.einsum('bsgc,gcd->bsgd', f, w_f.astype(jnp.float32))
    return y.reshape(B, S, GROUP_W).astype(a.dtype)


def spatial_gating(u, vv, v_g, w_s, b_s):
    B, S, _ = u.shape
    vh = rms_norm(vv.reshape(B, S, N_SGU_HEADS, SGU_W), v_g)
    vc = vh.reshape(B, S // CHUNK, CHUNK, N_SGU_HEADS, SGU_W)
    sp = jnp.einsum('hpq,bnqhc->bnphc', w_s, vc) + b_s.T[None, None, :, :, None]
    return u * sp.reshape(B, S, GROUP_W)


def memory_attention(cq, mem, mem_g, w_mem_kv):
    B, S, _ = cq.shape
    kv = rms_norm(mem, mem_g) @ w_mem_kv
    mk, mv = jnp.split(kv, 2, axis=-1)
    M = mem.shape[1]
    mk = mk.reshape(B, M, N_MEM_HEADS, MEM_HEAD_DIM)
    mv = mv.reshape(B, M, N_MEM_HEADS, MEM_HEAD_DIM)
    qh = cq.reshape(B, S, N_MEM_HEADS, MEM_HEAD_DIM)
    s = jnp.einsum('bshd,bmhd->bhsm', qh, mk, preferred_element_type=jnp.float32) * (MEM_HEAD_DIM ** -0.5)
    p = jax.nn.softmax(s, axis=-1)
    o = jnp.einsum('bhsm,bmhd->bshd', p.astype(mv.dtype), mv)
    return o.reshape(B, S, GROUP_W)


def hybrid_layer(x, mem, cos, sin, pre_g, w_in, q_g, k_g, w_f, v_g, w_s, b_s, mem_g, w_mem_kv, w_out, post_g):
    B, S, _ = x.shape
    h = rms_norm(x, pre_g)
    z = h @ w_in
    (aq, ak, av, ag, fa, fg, su, sv, sg, mq, mg) = jnp.split(z, SPLIT_POINTS, axis=-1)
    q = rms_norm(aq.reshape(B, S, N_HEADS, HEAD_DIM), q_g)
    k = rms_norm(ak.reshape(B, S, N_KV_HEADS, HEAD_DIM), k_g)
    v = av.reshape(B, S, N_KV_HEADS, HEAD_DIM)
    q = apply_axial_rope(q, cos, sin)
    k = apply_axial_rope(k, cos, sin)
    o_att = self_attention(q, k, v) * jax.nn.silu(ag)
    o_four = fourier_mix(fa, w_f) * jax.nn.silu(fg)
    o_sgu = spatial_gating(su, sv, v_g, w_s, b_s) * jax.nn.silu(sg)
    o_mem = memory_attention(mq, mem, mem_g, w_mem_kv) * jax.nn.silu(mg)
    o = jnp.concatenate([o_att, o_four, o_sgu, o_mem], axis=-1) @ w_out
    return x + rms_norm(o, post_g)


def trunk(x, mem, pre_norm_g, w_in, q_norm_g, k_norm_g, w_fourier, sgu_norm_g, w_spatial,
          b_spatial, mem_norm_g, w_mem_kv, w_out, post_norm_g):
    cos, sin = axial_rope_tables(x.shape[1])
    for l in range(DEPTH):
        x = hybrid_layer(x, mem, cos, sin, pre_norm_g[l], w_in[l], q_norm_g[l], k_norm_g[l],
                         w_fourier[l], sgu_norm_g[l], w_spatial[l], b_spatial[l],
                         mem_norm_g[l], w_mem_kv[l], w_out[l], post_norm_g[l])
    return x


def setup_inputs(seed: int = 0) -> dict:
    key = jax.random.key(seed)
    ks = jax.random.split(key, 17)
    f32 = jnp.float32
    nrm = lambda k, shp, s: jax.random.normal(k, shp, f32) * s
    gain = lambda k, shp: 1.0 + 0.02 * jax.random.normal(k, shp, f32)
    return {
        "x_prompt": nrm(ks[0], (BATCH, SEQ, D_MODEL), 1.0),
        "x_sample": nrm(ks[1], (DEC_BATCH, DEC_SEQ, D_MODEL), 1.0),
        "mem_prompt": nrm(ks[2], (BATCH, N_MEM, D_MODEL), 1.0),
        "mem_sample": nrm(ks[3], (DEC_BATCH, N_MEM, D_MODEL), 1.0),
        "pre_norm_g": gain(ks[4], (DEPTH, D_MODEL)),
        "w_in": nrm(ks[5], (DEPTH, D_MODEL, IN_W), D_MODEL ** -0.5),
        "q_norm_g": gain(ks[6], (DEPTH, HEAD_DIM)),
        "k_norm_g": gain(ks[7], (DEPTH, HEAD_DIM)),
        "w_fourier": nrm(ks[8], (DEPTH, N_FOURIER_GROUPS, FOURIER_W, FOURIER_W), FOURIER_W ** -0.5),
        "sgu_norm_g": gain(ks[9], (DEPTH, N_SGU_HEADS, SGU_W)),
        "w_spatial": nrm(ks[10], (DEPTH, N_SGU_HEADS, CHUNK, CHUNK), CHUNK ** -0.5),
        "b_spatial": nrm(ks[11], (DEPTH, N_SGU_HEADS, CHUNK), 0.02),
        "mem_norm_g": gain(ks[12], (DEPTH, D_MODEL)),
        "w_mem_kv": nrm(ks[13], (DEPTH, D_MODEL, 2 * GROUP_W), D_MODEL ** -0.5),
        "w_out": nrm(ks[14], (DEPTH, D_MIX, D_MODEL), D_MIX ** -0.5),
        "post_norm_g": gain(ks[15], (DEPTH, D_MODEL)),
    }


def reference(x_prompt, x_sample, mem_prompt, mem_sample, pre_norm_g, w_in, q_norm_g, k_norm_g,
              w_fourier, sgu_norm_g, w_spatial, b_spatial, mem_norm_g, w_mem_kv, w_out, post_norm_g):
    y_prompt = trunk(x_prompt, mem_prompt, pre_norm_g, w_in, q_norm_g, k_norm_g, w_fourier,
                     sgu_norm_g, w_spatial, b_spatial, mem_norm_g, w_mem_kv, w_out, post_norm_g)
    y_sample = trunk(x_sample, mem_sample, pre_norm_g, w_in, q_norm_g, k_norm_g, w_fourier,
                     sgu_norm_g, w_spatial, b_spatial, mem_norm_g, w_mem_kv, w_out, post_norm_g)
    return (y_prompt, y_sample)
```

```cpp
#include <hip/hip_runtime.h>
#include <hip/hip_cooperative_groups.h>
#include <hip/hip_bf16.h>
#include <cstdio>
#include <cstdint>
namespace cg = cooperative_groups;

typedef unsigned short bf16_t;
typedef short bf16x8 __attribute__((ext_vector_type(8)));
typedef short s16x4 __attribute__((ext_vector_type(4)));
typedef float f32x16 __attribute__((ext_vector_type(16)));
typedef float f32x4 __attribute__((ext_vector_type(4)));
typedef unsigned u32x4 __attribute__((ext_vector_type(4)));
typedef unsigned u32x2 __attribute__((ext_vector_type(2)));
#define LAS __attribute__((address_space(3)))

constexpr int DM = 1024, NTOK = 81920, NPROMPT_TOK = 16384, NZ = 5376, DMIX = 2048;
constexpr int CH_TOK = 16384, NCHUNK = 5, NMEMROWS = 8704;
constexpr int ZQ = 0, ZK = 512, ZV = 640, ZAG = 768, ZP = 1280, ZFG = 2304, ZSU = 2816, ZSV = 3328, ZSG = 3840, ZMQ = 4352, ZMG = 4864;
constexpr float EPS = 1e-6f;
constexpr int ZROWS = 49152, ZP_ = 128, ZBLKA = 21;
constexpr int NPHASE = 18;

constexpr size_t MiB = 1u << 20;
constexpr size_t OFF_XB = 0, OFF_O = 160 * MiB, OFF_ZY = 480 * MiB  , OFF_TB = 924 * MiB  , OFF_WIN = 832 * MiB, OFF_WFA = 854 * MiB,
                 OFF_WOUT = 856 * MiB, OFF_WMKV = 864 * MiB, OFF_MEMN = 868 * MiB, OFF_MKV = 885 * MiB, OFF_MISC = 919 * MiB;
constexpr size_t OFF_WCS = OFF_MISC, OFF_WSB = OFF_WCS + 524288, OFF_A1_64 = OFF_WSB + 262144, OFF_A1_128 = OFF_A1_64 + 8192,
                 OFF_A3_64 = OFF_A1_128 + 32768, OFF_A3_128 = OFF_A3_64 + 16384, OFF_TW8192 = OFF_A3_128 + 65536, OFF_TW2048 = OFF_TW8192 + 65536,
                 OFF_ROPE = OFF_TW2048 + 16384, OFF_BAR = 923 * MiB, OFF_RS2 = OFF_BAR + 512 * 1024  , WS_NEED = 1020 * MiB;
static_assert(OFF_ROPE + 2 * MiB <= OFF_BAR, "ws map");

struct Params { const float* in[16]; float* out; char* ws; int phase_lo, phase_hi; };

constexpr int LDS_HALF = 60416, LDS_TAB = 131072, LDS_XB = 132096, LDS_BYTES = 135168;

typedef float f32x2_t __attribute__((ext_vector_type(2))); typedef __bf16 bf16x2_t __attribute__((ext_vector_type(2)));
__device__ __forceinline__ unsigned pk2(float lo, float hi) { f32x2_t v = {lo, hi}; bf16x2_t b = __builtin_convertvector(v, bf16x2_t); return __builtin_bit_cast(unsigned, b); }
__device__ __forceinline__ unsigned f2bf(float f) { return pk2(f, 0.f) & 0xffffu; }
__device__ __forceinline__ float bf2f(unsigned h) { return __builtin_bit_cast(float, h << 16); }
__device__ __forceinline__ float silu(float x) { return x / (1.0f + __expf(-x)); }
__device__ __forceinline__ int crow(int r, int hi) { return (r & 3) + 8 * (r >> 2) + 4 * hi; }
__device__ __forceinline__ s16x4 tr16(LAS char* p) { return __builtin_bit_cast(s16x4, __builtin_amdgcn_ds_read_tr16_b64_v4i16((LAS s16x4*)p)); }
__device__ __forceinline__ int otid() { int t = threadIdx.x & 255; asm volatile("" : "+v"(t)); return t; }
__device__ __forceinline__ int vhalf() { return __builtin_amdgcn_readfirstlane((int)(threadIdx.x >> 8)); }
__device__ __forceinline__ int vblk() { return (int)blockIdx.x * 2 + vhalf(); }
__device__ __forceinline__ int vgrid() { return (int)gridDim.x * 2; }
__device__ __forceinline__ LAS char* vlds(LAS char* lds) { return lds + vhalf() * LDS_HALF; }
__device__ __forceinline__ float wave_sum(float v) {
#pragma unroll
  for (int o = 32; o >= 1; o >>= 1) v += __shfl_xor(v, o);
  return v;
}


#define XB_TMO      128
#define XB_XCNT(j)  (256  + 64 * (j))
#define XB_XSUB(j)  (1280 + 64 * (j))
#define XB_XGEN(j)  (2304 + 64 * (j))
#define XB_TOP      3328
#define XB_TOPGEN   3392
#define XCD_BAR_WORDS 3456
#define XB_SPIN_CAP (1u << 18)
__device__ __forceinline__ unsigned xb_ld(unsigned* p)              { return __hip_atomic_load(p, __ATOMIC_RELAXED, __HIP_MEMORY_SCOPE_AGENT); }
__device__ __forceinline__ unsigned xb_add(unsigned* p, unsigned v) { return __hip_atomic_fetch_add(p, v, __ATOMIC_RELAXED, __HIP_MEMORY_SCOPE_AGENT); }
__device__ __forceinline__ unsigned xb_xcc_id() { return (unsigned)__builtin_amdgcn_s_getreg((3 << 11) | 20) & 0xFu; }
#define XB_SPIN(cond, bar) do { unsigned _sp = 0; while (cond) { __builtin_amdgcn_s_sleep(1); \
    if ((++_sp & 255u) == 0u) { if (xb_ld(&(bar)[XB_TMO])) break; if (_sp > XB_SPIN_CAP) { atomicAdd(&(bar)[XB_TMO], 1u); break; } } } } while (0)
struct XcdBarrier { unsigned* bar; unsigned x; volatile LAS unsigned* st; };
__device__ __forceinline__ XcdBarrier xcd_barrier_post(unsigned* bar, volatile LAS unsigned* st) {
  XcdBarrier b; b.bar = bar; b.x = xb_xcc_id(); b.st = st;
  if (threadIdx.x == 0) (void)xb_add(&bar[XB_XCNT(b.x)], 1u);
  return b;
}
__device__ __forceinline__ void xcd_barrier_complete(unsigned* bar, unsigned x, unsigned& nloc, unsigned& nx) {
  const unsigned G = gridDim.x * gridDim.y * gridDim.z;
  unsigned sum, cnt, mine, sp = 0u;
  for (;;) {
    sum = 0u; cnt = 0u; mine = 0u;
#pragma unroll
    for (unsigned j = 0; j < 16; ++j) { const unsigned c = xb_ld(&bar[XB_XCNT(j)]); sum += c; cnt += (c > 0u) ? 1u : 0u; mine = (j == x) ? c : mine; }
    if (sum == G) break;
    __builtin_amdgcn_s_sleep(1);
    if ((++sp & 255u) == 0u) { if (xb_ld(&bar[XB_TMO])) break; if (sp > XB_SPIN_CAP) { atomicAdd(&bar[XB_TMO], 1u); break; } }
  }
  nloc = mine > 0u ? mine : 1u; nx = cnt > 0u ? cnt : 1u;
}
__device__ __forceinline__ void xcd_barrier(const XcdBarrier& b) {
  asm volatile("s_waitcnt vmcnt(0)" ::: "memory");
  __syncthreads();
  if (threadIdx.x == 0) {
    unsigned* bar = b.bar;
    __builtin_amdgcn_s_waitcnt(0);
    unsigned nloc = b.st[0], nx = b.st[1];
    if (nloc == 0u) { xcd_barrier_complete(bar, b.x, nloc, nx); b.st[0] = nloc; b.st[1] = nx; }
    const unsigned old = xb_add(&bar[XB_XSUB(b.x)], 1u);
    const unsigned gen = old / nloc;
    if (old + 1u == (gen + 1u) * nloc) {
      __builtin_amdgcn_fence(__ATOMIC_RELEASE, "agent");
      asm volatile("s_waitcnt vmcnt(0)" ::: "memory");
      const unsigned og = xb_add(&bar[XB_TOP], 1u);
      const unsigned tg = og / nx;
      if (og + 1u == (tg + 1u) * nx) xb_add(&bar[XB_TOPGEN], 1u);
      else XB_SPIN(xb_ld(&bar[XB_TOPGEN]) == tg, bar);
      __builtin_amdgcn_fence(__ATOMIC_ACQUIRE, "agent");
      xb_add(&bar[XB_XGEN(b.x)], 1u);
      asm volatile("s_waitcnt vmcnt(0)" ::: "memory");
    } else {
      XB_SPIN(xb_ld(&bar[XB_XGEN(b.x)]) == gen, bar);
      __builtin_amdgcn_fence(__ATOMIC_ACQUIRE, "agent");
      asm volatile("s_waitcnt vmcnt(0)" ::: "memory");
    }
  }
  __syncthreads();
}

namespace pg8 {
#define PG8_LAS __attribute__((address_space(3)))
typedef unsigned short bf16_t;
typedef short bf16x8 __attribute__((ext_vector_type(8)));
typedef float f32x4 __attribute__((ext_vector_type(4)));
typedef unsigned u32x4 __attribute__((ext_vector_type(4)));
constexpr int BM = 256, BK = 64, HALF = 128, HTB = HALF * BK * 2  , STAGE_BYTES = 8 * HTB, NXCD = 8, WGM = 4;

__host__ __device__ __forceinline__ int lds_byte(int r, int c) { const int st = (r >> 4) * 2 + (c >> 5), rr = r & 15, cc = c & 31, ob = rr * 64 + cc * 2; return st * 1024 + (ob ^ (((ob >> 9) & 1) << 5)); }
__host__ __device__ __forceinline__ void stage_rc(int b, int& R, int& C) { const int st = b / 1024, sb = b % 1024, swz = sb ^ (((sb >> 9) & 1) << 5); R = (st >> 1) * 16 + swz / 64; C = (st & 1) * 32 + (swz % 64) / 2; }
__host__ __device__ __forceinline__ int perm32(int rho) { const int n = rho >> 4, i = rho & 15; return 8 * (i >> 2) + 4 * n + (i & 3); }

struct Unit { int pm, pn; };
struct Gemm { const bf16_t* A; const bf16_t* Bt; int M, N, K; };

struct StaticOrder {
    int nM, nN, nwg, G, c;
    __host__ __device__ void init(int M, int N, int G_, int c_) { nM = M / BM; nN = N / BM; nwg = nM * nN; G = G_; c = c_; }
    __host__ __device__ bool next(int i, Unit& u) const {
        const long L = (long)i * G + c; if (L >= nwg) return false;
        int wgid = (int)L; { const int q = nwg / NXCD, r = nwg % NXCD, xcd = wgid % NXCD, off = wgid / NXCD; wgid = (xcd < r ? xcd * (q + 1) : r * (q + 1) + (xcd - r) * q) + off; }
        const int nig = WGM * nN, gid = wgid / nig, fm = gid * WGM, gsz = (nM - fm) < WGM ? (nM - fm) : WGM;
        u.pm = fm + ((wgid % nig) % gsz); u.pn = (wgid % nig) / gsz; return true;
    }
    __device__ __forceinline__ void a_ready(const Unit&) const {}
    __device__ __forceinline__ void done(const Unit&) const {}
};

__device__ __forceinline__ unsigned cvt_pk_bf16(float lo, float hi) { unsigned r; asm volatile("v_cvt_pk_bf16_f32 %0, %1, %2" : "=v"(r) : "v"(lo), "v"(hi)); return r; }
typedef float f32x2 __attribute__((ext_vector_type(2)));

struct EpiBf16 {
    static constexpr bool PERM = true, AFTER_DRAIN = false;
    bf16_t* O; int ldc;
    __device__ __forceinline__ void operator()(const f32x4 (&acc)[2][2][4][2], const Unit& u, int wr, int wc, int fr, int fq) const {
        const int row0 = u.pm * BM + wr * 64 + fr, col0 = u.pn * BM + wc * 32 + 8 * fq;
#pragma unroll
        for (int ai = 0; ai < 2; ++ai)
#pragma unroll
            for (int m = 0; m < 4; ++m) { bf16_t* rowp = O + (size_t)(row0 + ai * HALF + m * 16) * ldc + col0;
#pragma unroll
                for (int bj = 0; bj < 2; ++bj) { const f32x4 v0 = acc[ai][bj][m][0], v1 = acc[ai][bj][m][1];
                    u32x4 w; w.x = cvt_pk_bf16(v0[0], v0[1]); w.y = cvt_pk_bf16(v0[2], v0[3]); w.z = cvt_pk_bf16(v1[0], v1[1]); w.w = cvt_pk_bf16(v1[2], v1[3]);
                    *(u32x4*)(rowp + bj * HALF) = w; } }
    }
};
struct EpiBf16Blk {
    static constexpr bool PERM = true, AFTER_DRAIN = false;
    bf16_t* OA; bf16_t* OB; size_t zrows;
    __device__ __forceinline__ void operator()(const f32x4 (&acc)[2][2][4][2], const Unit& u, int wr, int wc, int fr, int fq) const {
        const int row0 = u.pm * BM + wr * 64 + fr, c0 = wc * 32 + 8 * fq;
#pragma unroll
        for (int bj = 0; bj < 2; ++bj) { const int bi = u.pn * 2 + bj; bf16_t* blk = (bi < 21 ? OA + (size_t)bi * zrows * 128 : OB + (size_t)(bi - 21) * zrows * 128) + c0;
#pragma unroll
            for (int ai = 0; ai < 2; ++ai)
#pragma unroll
                for (int m = 0; m < 4; ++m) { const f32x4 v0 = acc[ai][bj][m][0], v1 = acc[ai][bj][m][1];
                    u32x4 w; w.x = cvt_pk_bf16(v0[0], v0[1]); w.y = cvt_pk_bf16(v0[2], v0[3]); w.z = cvt_pk_bf16(v1[0], v1[1]); w.w = cvt_pk_bf16(v1[2], v1[3]);
                    *(u32x4*)(blk + (size_t)(row0 + ai * HALF + m * 16) * 128) = w; } }
    }
};
struct EpiF32 {
    static constexpr bool PERM = false, AFTER_DRAIN = false;
    float* O; int ldc;
    __device__ __forceinline__ void operator()(const f32x4 (&acc)[2][2][4][2], const Unit& u, int wr, int wc, int fr, int fq) const {
        const int row0 = u.pm * BM + wr * 64 + fr, col0 = u.pn * BM + wc * 32 + 4 * fq;
#pragma unroll
        for (int ai = 0; ai < 2; ++ai)
#pragma unroll
            for (int m = 0; m < 4; ++m) { float* rowp = O + (size_t)(row0 + ai * HALF + m * 16) * ldc + col0;
#pragma unroll
                for (int bj = 0; bj < 2; ++bj)
#pragma unroll
                    for (int n = 0; n < 2; ++n) *(f32x4*)(rowp + bj * HALF + n * 16) = acc[ai][bj][m][n]; }
    }
};
struct CutOrder : StaticOrder { int imax;
    __host__ __device__ bool next(int i, Unit& u) const { if (i >= imax) return false; return StaticOrder::next(i, u); } };
template <class Epi, class Sched, bool ALIGN_EPI = false, bool SP2 = false>
__device__ __forceinline__ void gemm_phase(PG8_LAS unsigned char* lds, const Gemm g, const Sched& S, const Epi& E) {
    int tid_ = threadIdx.x; asm volatile("" : "+v"(tid_));
    const int tid = tid_, wid = __builtin_amdgcn_readfirstlane(tid >> 6), lane = tid & 63, wr = wid >> 2, wc = wid & 3, fr = lane & 15, fq = lane >> 4;
    const int K = g.K, nt = K / BK;
    unsigned voffA[2], voffB[2];
#pragma unroll
    for (int i = 0; i < 2; ++i) { int R, C; stage_rc(tid * 16 + i * 8192, R, C); const int Rb = Epi::PERM ? ((R & ~31) + perm32(R & 31)) : R;
        voffA[i] = (unsigned)(R * K + C) * 2u; voffB[i] = (unsigned)(Rb * K + C) * 2u; }
    const size_t kstep = (size_t)(BK * 2);
    const size_t hstep = (size_t)HALF * K * 2;
    const size_t tstep = 2 * hstep;
    const unsigned ldsw = (unsigned)wid * 1024u;
    const int aoff = lds_byte(wr * 64 + fr, fq * 8), boff = lds_byte(wc * 32 + fr, fq * 8);
#define PG8_SA(b, h) (((b) * 2 + (h)) * HTB)
#define PG8_SB(b, h) ((4 + (b) * 2 + (h)) * HTB)
#define PG8_STAGE(bufoff, gbase, voff) do { _Pragma("unroll") for (int _i = 0; _i < 2; ++_i) \
        __builtin_amdgcn_global_load_lds((const unsigned*)((const char*)(gbase) + (voff)[_i]), (PG8_LAS unsigned*)(lds + (bufoff) + ldsw + _i * 8192), 16, 0, 0); } while (0)
#define PG8_LDA(dst, b, h) do { _Pragma("unroll") for (int m = 0; m < 4; ++m) _Pragma("unroll") for (int k = 0; k < 2; ++k) dst[m][k] = *(const PG8_LAS bf16x8*)(lds + PG8_SA(b, h) + aoff + m * 2048 + k * 1024); } while (0)
#define PG8_LDB(dst, b, h) do { _Pragma("unroll") for (int n = 0; n < 2; ++n) _Pragma("unroll") for (int k = 0; k < 2; ++k) dst[n][k] = *(const PG8_LAS bf16x8*)(lds + PG8_SB(b, h) + boff + n * 2048 + k * 1024); } while (0)
#define PG8_MMA(ai, bj, At, Bt) do { __builtin_amdgcn_s_setprio(1); _Pragma("unroll") for (int m = 0; m < 4; ++m) _Pragma("unroll") for (int n = 0; n < 2; ++n) _Pragma("unroll") for (int k = 0; k < 2; ++k) \
        acc[ai][bj][m][n] = __builtin_amdgcn_mfma_f32_16x16x32_bf16(Bt[n][k], At[m][k], acc[ai][bj][m][n], 0, 0, 0); __builtin_amdgcn_s_setprio(0); } while (0)
#define PG8_WAIT_V(n) asm volatile("s_waitcnt vmcnt(" #n ")" ::: "memory")
#define PG8_WAIT_L(n) asm volatile("s_waitcnt lgkmcnt(" #n ")" ::: "memory")
#define PG8_BAR __builtin_amdgcn_s_barrier()
#define PG8_SCHED __builtin_amdgcn_sched_barrier(0)
    Unit cur, nxt; int ui = 0;
    if (!S.next(0, cur)) return;
    f32x4 acc[2][2][4][2];
#pragma unroll
    for (int a = 0; a < 2; ++a)
#pragma unroll
        for (int b = 0; b < 2; ++b)
#pragma unroll
            for (int m = 0; m < 4; ++m)
#pragma unroll
                for (int n = 0; n < 2; ++n) acc[a][b][m][n] = (f32x4){0.f, 0.f, 0.f, 0.f};
    bf16x8 At[4][2], B0[2][2], B1[2][2];
    const char* cA = (const char*)g.A + (size_t)cur.pm * tstep; const char* cB = (const char*)g.Bt + (size_t)cur.pn * tstep;
    S.a_ready(cur);
    if constexpr (SP2) {
        PG8_STAGE(PG8_SB(0, 0), cB, voffB); PG8_STAGE(PG8_SB(0, 1), cB + hstep, voffB); PG8_STAGE(PG8_SA(0, 0), cA, voffA); PG8_STAGE(PG8_SA(0, 1), cA + hstep, voffA);
        if (wr == 1) PG8_BAR;
        PG8_WAIT_V(2); PG8_BAR;
        PG8_STAGE(PG8_SB(1, 0), cB + kstep, voffB); PG8_STAGE(PG8_SA(1, 0), cA + kstep, voffA); PG8_STAGE(PG8_SB(1, 1), cB + hstep + kstep, voffB);
        PG8_WAIT_V(6); PG8_BAR;
    } else {
        PG8_STAGE(PG8_SB(0, 0), cB, voffB); PG8_STAGE(PG8_SA(0, 0), cA, voffA); PG8_STAGE(PG8_SB(0, 1), cB + hstep, voffB); PG8_STAGE(PG8_SA(0, 1), cA + hstep, voffA);
        if (wr == 1) PG8_BAR;
        PG8_WAIT_V(4); PG8_BAR;
        PG8_STAGE(PG8_SB(1, 0), cB + kstep, voffB); PG8_STAGE(PG8_SA(1, 0), cA + kstep, voffA); PG8_STAGE(PG8_SB(1, 1), cB + hstep + kstep, voffB);
        PG8_WAIT_V(6); PG8_BAR;
    }
    for (;;) {
        const bool has_next = S.next(ui + 1, nxt);
        const char* nA = has_next ? (const char*)g.A + (size_t)nxt.pm * tstep : cA; const char* nB = has_next ? (const char*)g.Bt + (size_t)nxt.pn * tstep : cB;
        for (int t = 0; t < nt; t += 2) {
            const bool last = (t == nt - 2);
            const char* a1 = cA + (size_t)(t + 1) * kstep;
            const char* a2 = last ? nA : cA + (size_t)(t + 2) * kstep; const char* b2 = last ? nB : cB + (size_t)(t + 2) * kstep;
            const char* a3 = a2 + kstep; const char* b3 = b2 + kstep;
            if (last && has_next) S.a_ready(nxt);
            if constexpr (SP2) {
            PG8_LDB(B0, 0, 0); PG8_LDB(B1, 0, 1); PG8_SCHED; PG8_LDA(At, 0, 0); PG8_STAGE(PG8_SA(1, 1), a1 + hstep, voffA);
            PG8_WAIT_V(8); PG8_WAIT_L(0); PG8_BAR; PG8_MMA(0, 0, At, B0); PG8_MMA(0, 1, At, B1); PG8_BAR; PG8_SCHED;
            PG8_LDA(At, 0, 1); PG8_STAGE(PG8_SB(0, 0), b2, voffB); PG8_STAGE(PG8_SB(0, 1), b2 + hstep, voffB); PG8_STAGE(PG8_SA(0, 0), a2, voffA);
            PG8_WAIT_V(8); PG8_WAIT_L(0); PG8_BAR; PG8_MMA(1, 0, At, B0); PG8_MMA(1, 1, At, B1); PG8_BAR; PG8_SCHED;
            PG8_LDB(B0, 1, 0); PG8_LDB(B1, 1, 1); PG8_SCHED; PG8_LDA(At, 1, 0); PG8_STAGE(PG8_SA(0, 1), a2 + hstep, voffA);
            PG8_WAIT_V(8); PG8_WAIT_L(0); PG8_BAR; PG8_MMA(0, 0, At, B0); PG8_MMA(0, 1, At, B1); PG8_BAR; PG8_SCHED;
            PG8_LDA(At, 1, 1); PG8_STAGE(PG8_SB(1, 0), b3, voffB); PG8_STAGE(PG8_SB(1, 1), b3 + hstep, voffB); PG8_STAGE(PG8_SA(1, 0), a3, voffA);
            PG8_WAIT_V(8); PG8_WAIT_L(0); PG8_BAR; PG8_MMA(1, 0, At, B0); PG8_MMA(1, 1, At, B1); PG8_BAR; PG8_SCHED;
            } else {
            PG8_LDB(B0, 0, 0); PG8_SCHED; PG8_LDA(At, 0, 0); PG8_STAGE(PG8_SA(1, 1), a1 + hstep, voffA);
            PG8_WAIT_L(8); PG8_BAR; PG8_WAIT_L(0); PG8_MMA(0, 0, At, B0); PG8_BAR; PG8_SCHED;
            PG8_LDB(B1, 0, 1); PG8_STAGE(PG8_SB(0, 0), b2, voffB);
            PG8_BAR; PG8_WAIT_L(0); PG8_MMA(0, 1, At, B1); PG8_BAR;
            PG8_LDA(At, 0, 1); PG8_STAGE(PG8_SA(0, 0), a2, voffA);
            PG8_BAR; PG8_WAIT_L(0); PG8_MMA(1, 0, At, B0); PG8_BAR; PG8_SCHED;
            PG8_STAGE(PG8_SB(0, 1), b2 + hstep, voffB);
            PG8_WAIT_V(6); PG8_BAR; PG8_MMA(1, 1, At, B1); PG8_BAR;
            PG8_LDB(B0, 1, 0); PG8_SCHED; PG8_LDA(At, 1, 0); PG8_STAGE(PG8_SA(0, 1), a2 + hstep, voffA);
            PG8_WAIT_L(8); PG8_BAR; PG8_WAIT_L(0); PG8_MMA(0, 0, At, B0); PG8_BAR; PG8_SCHED;
            PG8_LDB(B1, 1, 1); PG8_STAGE(PG8_SB(1, 0), b3, voffB);
            PG8_BAR; PG8_WAIT_L(0); PG8_MMA(0, 1, At, B1); PG8_BAR;
            PG8_LDA(At, 1, 1); PG8_STAGE(PG8_SA(1, 0), a3, voffA);
            PG8_BAR; PG8_WAIT_L(0); PG8_MMA(1, 0, At, B0); PG8_BAR; PG8_SCHED;
            PG8_STAGE(PG8_SB(1, 1), b3 + hstep, voffB);
            PG8_WAIT_V(6); PG8_BAR; PG8_MMA(1, 1, At, B1); PG8_BAR;
            }
        }
        if constexpr (ALIGN_EPI) { if (wr == 0) PG8_BAR; }
        if constexpr (!Epi::AFTER_DRAIN) { E(acc, cur, wr, wc, fr, fq); S.done(cur); }
        if (!has_next) break;
#pragma unroll
        for (int a = 0; a < 2; ++a)
#pragma unroll
            for (int b = 0; b < 2; ++b)
#pragma unroll
                for (int m = 0; m < 4; ++m)
#pragma unroll
                    for (int n = 0; n < 2; ++n) acc[a][b][m][n] = (f32x4){0.f, 0.f, 0.f, 0.f};
        cur = nxt; cA = nA; cB = nB; ++ui;
        if constexpr (ALIGN_EPI) { if (wr == 1) PG8_BAR; }
    }
    PG8_WAIT_V(0);
    if constexpr (!ALIGN_EPI) { if (wr == 0) PG8_BAR; }
    PG8_BAR;
    if constexpr (Epi::AFTER_DRAIN) { E.fused(acc, cur, wr, wc, fr, fq, lds, wid, lane); S.done(cur); }
#undef PG8_SA
#undef PG8_SB
#undef PG8_STAGE
#undef PG8_LDA
#undef PG8_LDB
#undef PG8_MMA
#undef PG8_WAIT_V
#undef PG8_WAIT_L
#undef PG8_BAR
#undef PG8_SCHED
}
}

namespace attn_body {
using bf16=__hip_bfloat16;
using bf16x8=__attribute__((ext_vector_type(8)))short;
using s16x4=__attribute__((ext_vector_type(4)))short;
using f32x16=__attribute__((ext_vector_type(16)))float;
using u32x4=__attribute__((ext_vector_type(4)))unsigned;
constexpr int D=64,QP=128,OP=2048;
constexpr int NW=8,QBLK=32,QB=QBLK*NW,KVBLK=64;
__device__ __forceinline__ int crow(int r,int hi){return (r&3)+8*(r>>2)+4*hi;}
#define SBAR() __builtin_amdgcn_sched_barrier(0)
__device__ __forceinline__ void cmask(f32x16&p0,f32x16&p1,int jb,int qrel,int hi){
  const float NEG=-INFINITY; int kb=64*jb+4*hi;
  #pragma unroll
  for(int r=0;r<16;++r){int kv=kb+(r&3)+8*(r>>2); if(kv>qrel)p0[r]=NEG; if(kv+32>qrel)p1[r]=NEG;}
}

constexpr int NSLOT=3, SLOTB=8192;
constexpr int LDS_K=0, LDS_V=NSLOT*SLOTB, LDS_WS=2*NSLOT*SLOTB, LDS_OST=LDS_WS+NW*64*4, LDS_BYTES=LDS_OST+NW*4096;
constexpr float C2=0.125f*1.4426950408889634f;
__device__ __forceinline__ void glds16(const void*gsrc,unsigned lds_dst){unsigned keep;
  asm volatile("s_mov_b32 %0, m0\n\ts_mov_b32 m0, %2\n\ts_nop 0\n\tglobal_load_lds_dwordx4 %1, off\n\ts_mov_b32 m0, %0":"=&s"(keep):"v"(gsrc),"s"(lds_dst):"memory");}
__device__ __forceinline__ float max3f(float a,float b,float c){float r;asm("v_max3_f32 %0, %1, %2, %3":"=v"(r):"v"(a),"v"(b),"v"(c));return r;}
__device__ __forceinline__ float max2f(float a,float b){float r;asm("v_max_f32_e32 %0, %1, %2":"=v"(r):"v"(a),"v"(b));return r;}
__device__ __forceinline__ float fadd_s(float a,float b){float r;asm("v_add_f32_e32 %0, %1, %2":"=v"(r):"v"(a),"v"(b));return r;}
__device__ __forceinline__ float fsub_s(float a,float b){float r;asm("v_sub_f32_e32 %0, %1, %2":"=v"(r):"v"(a),"v"(b));return r;}
typedef float f32x2_t __attribute__((ext_vector_type(2))); typedef __bf16 bf16x2_t __attribute__((ext_vector_type(2)));
__device__ __forceinline__ unsigned cvtpk_s(float lo,float hi){f32x2_t v={lo,hi};bf16x2_t b=__builtin_convertvector(v,bf16x2_t);return __builtin_bit_cast(unsigned,b);}
#define WAIT_BAR(N) asm volatile("s_waitcnt vmcnt(" #N ") lgkmcnt(0)\n\ts_barrier":::"memory")

__device__ __forceinline__ void qkt(f32x16&p0,f32x16&p1,const char*Kslot,const bf16x8*qr,const f32x16&negm,int r32,int hi){
  const char*kb=Kslot+hi*1024+r32*16;
  #pragma unroll
  for(int d0=0;d0<4;++d0){
    const bf16x8 b0=*reinterpret_cast<const bf16x8*>(kb+d0*2048);
    const bf16x8 b1=*reinterpret_cast<const bf16x8*>(kb+d0*2048+512);
    if(d0==0){p0=__builtin_amdgcn_mfma_f32_32x32x16_bf16(b0,qr[0],negm,0,0,0);p1=__builtin_amdgcn_mfma_f32_32x32x16_bf16(b1,qr[0],negm,0,0,0);}
    else{p0=__builtin_amdgcn_mfma_f32_32x32x16_bf16(b0,qr[d0],p0,0,0,0);p1=__builtin_amdgcn_mfma_f32_32x32x16_bf16(b1,qr[d0],p1,0,0,0);}}
}
typedef __attribute__((address_space(3))) const char* lds_cptr;
typedef short v4i16_t __attribute__((ext_vector_type(4)));
__device__ __forceinline__ void kload8(bf16x8*kf,lds_cptr kp){
  kf[0]=*(const __attribute__((address_space(3))) bf16x8*)(kp);      kf[1]=*(const __attribute__((address_space(3))) bf16x8*)(kp+512);
  kf[2]=*(const __attribute__((address_space(3))) bf16x8*)(kp+2048); kf[3]=*(const __attribute__((address_space(3))) bf16x8*)(kp+2560);
  kf[4]=*(const __attribute__((address_space(3))) bf16x8*)(kp+4096); kf[5]=*(const __attribute__((address_space(3))) bf16x8*)(kp+4608);
  kf[6]=*(const __attribute__((address_space(3))) bf16x8*)(kp+6144); kf[7]=*(const __attribute__((address_space(3))) bf16x8*)(kp+6656);
}
__device__ __forceinline__ void kload2(bf16x8*kf,lds_cptr kp,int j){ kf[2*j]=*(const __attribute__((address_space(3))) bf16x8*)(kp+j*2048); kf[2*j+1]=*(const __attribute__((address_space(3))) bf16x8*)(kp+j*2048+512); }
__device__ __forceinline__ s16x4 vtr(lds_cptr p){ return __builtin_bit_cast(s16x4,__builtin_amdgcn_ds_read_tr16_b64_v4i16((__attribute__((address_space(3))) v4i16_t*)p)); }
__device__ __forceinline__ float rowmax(const f32x16&p0,const f32x16&p1){
  float a=max3f(p0[0],p0[1],p1[0]),b=max3f(p0[2],p0[3],p1[1]);a=max3f(a,p1[2],p1[3]);
  #pragma unroll
  for(int r=4;r<16;r+=4){a=max3f(a,p0[r],p0[r+1]);b=max3f(b,p0[r+2],p0[r+3]);a=max3f(a,p1[r],p1[r+1]);b=max3f(b,p1[r+2],p1[r+3]);}
  const float m=max2f(a,b);
  auto rr=__builtin_amdgcn_permlane32_swap(__float_as_uint(m),__float_as_uint(m),false,false);
  return max2f(__uint_as_float(rr[0]),__uint_as_float(rr[1]));
}
__device__ __forceinline__ void pv(f32x16*o,int vb,bf16x8 pa0,bf16x8 pa1,bf16x8 pa2,bf16x8 pa3){
  #pragma unroll
  for(int d0=0;d0<2;++d0){s16x4 lo[4],hi[4];
    #pragma unroll
    for(int ks=0;ks<4;++ks){
      asm volatile("ds_read_b64_tr_b16 %0,%1 offset:%c2":"=&v"(lo[ks]):"v"(vb),"i"(d0*4096+ks*1024):"memory");
      asm volatile("ds_read_b64_tr_b16 %0,%1 offset:%c2":"=&v"(hi[ks]):"v"(vb),"i"(d0*4096+ks*1024+512):"memory");}
    asm volatile("s_waitcnt lgkmcnt(0)":::"memory");SBAR();
    #define PK(k) (bf16x8){lo[k][0],lo[k][1],lo[k][2],lo[k][3],hi[k][0],hi[k][1],hi[k][2],hi[k][3]}
    o[d0]=__builtin_amdgcn_mfma_f32_32x32x16_bf16(pa0,PK(0),o[d0],0,0,0);
    o[d0]=__builtin_amdgcn_mfma_f32_32x32x16_bf16(pa1,PK(1),o[d0],0,0,0);
    o[d0]=__builtin_amdgcn_mfma_f32_32x32x16_bf16(pa2,PK(2),o[d0],0,0,0);
    o[d0]=__builtin_amdgcn_mfma_f32_32x32x16_bf16(pa3,PK(3),o[d0],0,0,0);
    #undef PK
  }
}

#ifndef ATTN_STORE16
#define ATTN_STORE16(p,v) (*(u32x4*)(p)=(v))
#endif
template<int THRL> __device__ __forceinline__ void attn_unit(const bf16*Qw0,const bf16*__restrict__ Kh,const bf16*__restrict__ Vh,const bf16*Gw0,bf16*Ow0,const int NT,char*shm,const float*qgain,const float*rope0){
  int tid_=threadIdx.x; asm volatile("":"+v"(tid_)); const int tid=tid_,lane=tid&63,r32=lane&31,hi=lane>>5; const int wid=__builtin_amdgcn_readfirstlane(tid>>6);
  const bf16*Qw=Qw0+(long)wid*QBLK*QP;
  const unsigned lds0=(unsigned)(uintptr_t)shm;
  float*wsf=(float*)(shm+LDS_WS)+wid*64;
  const bf16*ksrc=Kh+(long)lane*QP+wid*8;
  const bf16*vsrc=Vh+(long)(16*(wid&3)+(lane>>2))*QP+(wid>>2)*32+(lane&3)*8;
  const unsigned kdst=lds0+LDS_K+wid*1024, vdst=lds0+LDS_V+wid*1024;
  #define DMA_K(t,slot) glds16(ksrc+(long)(t)*KVBLK*QP,(unsigned)__builtin_amdgcn_readfirstlane(kdst+(slot)))
  #define DMA_V(t,slot) glds16(vsrc+(long)(t)*KVBLK*QP,(unsigned)__builtin_amdgcn_readfirstlane(vdst+(slot)))
  const int vb0=(int)(lds0+LDS_V)+((lane>>4)&1)*32+(lane&3)*8+(4*hi+((lane&15)>>2))*64;
  const char*Kbase=shm+LDS_K; bf16x8 kf[8];
  const lds_cptr shm3=(lds_cptr)shm; const lds_cptr kp0=shm3+LDS_K+hi*1024+r32*16; const lds_cptr vp0=shm3+LDS_V+((lane>>4)&1)*32+(lane&3)*8+(4*hi+((lane&15)>>2))*64;
  DMA_K(0,0);DMA_V(0,0);DMA_K(1,SLOTB);
  bf16x8 qr[4];
  #pragma unroll
  for(int d0=0;d0<4;++d0)qr[d0]=*reinterpret_cast<const bf16x8*>(&Qw[(long)r32*QP+d0*16+hi*8]);
  { float qf[4][8]; float ss=0.f;
    #pragma unroll
    for(int d0=0;d0<4;++d0){
      #pragma unroll
      for(int j=0;j<8;++j){ qf[d0][j]=__uint_as_float(((unsigned)(unsigned short)qr[d0][j])<<16); ss+=qf[d0][j]*qf[d0][j]; } }
    ss+=__shfl_xor(ss,32); const float rs=rsqrtf(ss*(1.0f/64.0f)+1e-6f);
    const float*rp=rope0+(long)(wid*QBLK+r32)*64;
    #pragma unroll
    for(int d0=0;d0<4;++d0){
      #pragma unroll
      for(int j=0;j<8;++j) qf[d0][j]*=rs*qgain[16*d0+8*hi+j]; }
    #pragma unroll
    for(int a=0;a<2;++a){
      #pragma unroll
      for(int j=0;j<8;++j){ const float co=rp[a*16+8*hi+j],si=rp[32+a*16+8*hi+j]; const float x1=qf[2*a][j],x2=qf[2*a+1][j]; qf[2*a][j]=(x1*co-x2*si)*C2; qf[2*a+1][j]=(x2*co+x1*si)*C2; } }
    #pragma unroll
    for(int d0=0;d0<4;++d0){ u32x4 w; w[0]=cvtpk_s(qf[d0][0],qf[d0][1]); w[1]=cvtpk_s(qf[d0][2],qf[d0][3]); w[2]=cvtpk_s(qf[d0][4],qf[d0][5]); w[3]=cvtpk_s(qf[d0][6],qf[d0][7]); qr[d0]=__builtin_bit_cast(bf16x8,w); } }
  float mhat=0.f,l_reg=0.f;f32x16 o[2];o[0]=f32x16{};o[1]=f32x16{};f32x16 negm=f32x16{};asm volatile("":"+v"(negm));
  #define CMASK(P0,P1,t) do{}while(0)
  bool resc=false;
  #define START(P0,P1) do{ const float rm=rowmax(P0,P1); resc=false; \
    { const float dl=rm; mhat=fadd_s(mhat,dl); \
      _Pragma("unroll") for(int r=0;r<16;++r){P0[r]=fsub_s(P0[r],dl);P1[r]=fsub_s(P1[r],dl);} \
      _Pragma("unroll") for(int r=0;r<16;++r)negm[r]=-mhat; asm volatile("":"+v"(negm)); } \
    _Pragma("unroll") for(int r=0;r<16;++r)P0[r]=__builtin_amdgcn_exp2f(P0[r]); }while(0)
  #define RESC() do{ if(resc){ asm volatile("s_waitcnt lgkmcnt(0)":::"memory"); \
      _Pragma("unroll") for(int d_=0;d_<2;++d_) _Pragma("unroll") for(int r=0;r<16;++r)o[d_][r]*=wsf[crow(r,hi)]; } }while(0)
  f32x16 pA0,pA1,pB0,pB1;
  int sl_prev=0,sl_cur=0,sl_next=SLOTB;
  #define ROT() do{sl_prev=sl_cur;sl_cur=sl_next;sl_next=(sl_next==(NSLOT-1)*SLOTB)?0:sl_next+SLOTB;}while(0)
  DMA_K(2,2*SLOTB);
  WAIT_BAR(3);
  qkt(pA0,pA1,Kbase,qr,negm,r32,hi);asm volatile("s_nop 15\n\ts_nop 7":"+v"(pA0),"+v"(pA1));CMASK(pA0,pA1,0);
  START(pA0,pA1);
  _Pragma("unroll") for(int r=0;r<16;++r)pA1[r]=__builtin_amdgcn_exp2f(pA1[r]);
  WAIT_BAR(0);
  DMA_K(3,0);DMA_V(1,SLOTB);
  ROT();
  kload8(kf,kp0+sl_cur);
  WAIT_BAR(2);
  s16x4 vlo[8],vhi[8]; u32x4 pw0,pw1,pw2,pw3;
  #define PKW(P,B) cvtpk_s(P[B],P[B+1])
  #define PAF(k) __builtin_bit_cast(bf16x8,pw##k)
  #define VFR(i) (bf16x8){vlo[i][0],vlo[i][1],vlo[i][2],vlo[i][3],vhi[i][0],vhi[i][1],vhi[i][2],vhi[i][3]}
  #define PIN(x) asm volatile("":"+v"(x))
  #define MX3(a,b,c) __builtin_fmaxf(__builtin_fmaxf((a),(b)),(c))
  #define GAPA(MF,A0,A1,A2,A3,W0,W1,PW) do{ MF; sacc+=A0; sacc+=A1; sacc+=A2; sacc+=A3; PIN(sacc); W0; W1; PIN(PW); SBAR(); }while(0)
  #define EX(v) __builtin_amdgcn_exp2f(v)
  #define GAPB(MF,X,B) do{ MF; X[B]=EX(X[B]); X[B+1]=EX(X[B+1]); X[B+2]=EX(X[B+2]); X[B+3]=EX(X[B+3]); PIN(X); SBAR(); }while(0)
  #define VRD(i) do{ vlo[i]=vtr(vp_+(((i)>>2)*4096+((i)&3)*1024)); vhi[i]=vtr(vp_+(((i)>>2)*4096+((i)&3)*1024+512)); }while(0)
  #define KRD(G,j) do{ if(G){ kload2(kf,kp0+sl_next,j); SBAR(); } }while(0)
  #define STEP(C0,C1,P0,P1,t,GK,GV,GL) do{ SBAR(); \
    const lds_cptr vp_=vp0+sl_prev; \
    VRD(0); SBAR(); float sacc=(P0[0]+P0[1]); \
    GAPA(C0=__builtin_amdgcn_mfma_f32_32x32x16_bf16(kf[0],qr[0],negm,0,0,0), P0[2],P0[3],P0[4],P0[5],     pw0[0]=PKW(P0,0), pw0[1]=PKW(P0,2), pw0); \
    VRD(4); SBAR(); GAPA(C1=__builtin_amdgcn_mfma_f32_32x32x16_bf16(kf[1],qr[0],negm,0,0,0), P0[6],P0[7],P0[8],P0[9],     pw0[2]=PKW(P0,4), pw0[3]=PKW(P0,6), pw0); \
    VRD(1); SBAR(); GAPA(C0=__builtin_amdgcn_mfma_f32_32x32x16_bf16(kf[2],qr[1],C0,0,0,0),   P0[10],P0[11],P0[12],P0[13], pw1[0]=PKW(P0,8), pw1[1]=PKW(P0,10), pw1); \
    VRD(5); SBAR(); GAPA(C1=__builtin_amdgcn_mfma_f32_32x32x16_bf16(kf[3],qr[1],C1,0,0,0),   P0[14],P0[15],P1[0],P1[1],   pw1[2]=PKW(P0,12),pw1[3]=PKW(P0,14), pw1); \
    VRD(2); SBAR(); GAPA(C0=__builtin_amdgcn_mfma_f32_32x32x16_bf16(kf[4],qr[2],C0,0,0,0),   P1[2],P1[3],P1[4],P1[5],     pw2[0]=PKW(P1,0), pw2[1]=PKW(P1,2), pw2); \
    VRD(6); SBAR(); GAPA(C1=__builtin_amdgcn_mfma_f32_32x32x16_bf16(kf[5],qr[2],C1,0,0,0),   P1[6],P1[7],P1[8],P1[9],     pw2[2]=PKW(P1,4), pw2[3]=PKW(P1,6), pw2); \
    VRD(3); SBAR(); GAPA(C0=__builtin_amdgcn_mfma_f32_32x32x16_bf16(kf[6],qr[3],C0,0,0,0),   P1[10],P1[11],P1[12],P1[13], pw3[0]=PKW(P1,8), pw3[1]=PKW(P1,10), pw3); \
    VRD(7); SBAR(); GAPA(C1=__builtin_amdgcn_mfma_f32_32x32x16_bf16(kf[7],qr[3],C1,0,0,0),   P1[14],P1[15],0.f,0.f,       pw3[2]=PKW(P1,12),pw3[3]=PKW(P1,14), pw3); \
    l_reg+=sacc; \
    if(GK){DMA_K((t)+3,sl_cur);} if(GV){DMA_V((t)+1,sl_next);} \
    CMASK(C0,C1,t); \
    { float a=MX3(C0[0],C0[1],C1[0]),b=MX3(C0[2],C0[3],C1[1]); a=MX3(a,C1[2],C1[3]); \
      _Pragma("unroll") for(int r=4;r<16;r+=4){a=MX3(a,C0[r],C0[r+1]);b=MX3(b,C0[r+2],C0[r+3]);a=MX3(a,C1[r],C1[r+1]);b=MX3(b,C1[r+2],C1[r+3]);} \
      float rm=__builtin_fmaxf(a,b); { auto rr=__builtin_amdgcn_permlane32_swap(__float_as_uint(rm),__float_as_uint(rm),false,false); rm=__builtin_fmaxf(__uint_as_float(rr[0]),__uint_as_float(rr[1])); } \
      resc=false; \
      if(__builtin_expect(__any(rm>(float)THRL),0)){ const float dl=__builtin_fmaxf(rm,0.f); mhat+=dl; \
        _Pragma("unroll") for(int r=0;r<16;++r){C0[r]-=dl;C1[r]-=dl;} \
        _Pragma("unroll") for(int r=0;r<16;++r)negm[r]=-mhat; asm volatile("":"+v"(negm)); \
        const float f=__builtin_amdgcn_exp2f(-dl); l_reg*=f; if(hi==0)wsf[r32]=f; resc=true; } } \
    SBAR(); \
    GAPB(o[0]=__builtin_amdgcn_mfma_f32_32x32x16_bf16(PAF(0),VFR(0),o[0],0,0,0), C0,0); \
    GAPB(o[1]=__builtin_amdgcn_mfma_f32_32x32x16_bf16(PAF(0),VFR(4),o[1],0,0,0), C0,4); \
    KRD(GL,0); GAPB(o[0]=__builtin_amdgcn_mfma_f32_32x32x16_bf16(PAF(1),VFR(1),o[0],0,0,0), C0,8); \
    KRD(GL,1); GAPB(o[1]=__builtin_amdgcn_mfma_f32_32x32x16_bf16(PAF(1),VFR(5),o[1],0,0,0), C0,12); \
    KRD(GL,2); GAPB(o[0]=__builtin_amdgcn_mfma_f32_32x32x16_bf16(PAF(2),VFR(2),o[0],0,0,0), C1,0); \
    KRD(GL,3); GAPB(o[1]=__builtin_amdgcn_mfma_f32_32x32x16_bf16(PAF(2),VFR(6),o[1],0,0,0), C1,4); \
    GAPB(o[0]=__builtin_amdgcn_mfma_f32_32x32x16_bf16(PAF(3),VFR(3),o[0],0,0,0), C1,8); \
    GAPB(o[1]=__builtin_amdgcn_mfma_f32_32x32x16_bf16(PAF(3),VFR(7),o[1],0,0,0), C1,12); \
    }while(0)
  int t=1;
  for(;t+5<NT;t+=2){
    STEP(pB0,pB1,pA0,pA1,t,true,true,true);     WAIT_BAR(2); RESC(); ROT();
    STEP(pA0,pA1,pB0,pB1,t+1,true,true,true);   WAIT_BAR(2); RESC(); ROT();
  }
  #define ENDW(tt) do{ if((tt)+3<NT){WAIT_BAR(2);} else if((tt)+2<NT){WAIT_BAR(1);} else {WAIT_BAR(0);} }while(0)
  for(;t+1<NT;t+=2){
    STEP(pB0,pB1,pA0,pA1,t,(t+3<NT),(t+1<NT),(t+1<NT));       ENDW(t);   RESC(); ROT();
    STEP(pA0,pA1,pB0,pB1,t+1,(t+4<NT),(t+2<NT),(t+2<NT));     ENDW(t+1); RESC(); ROT();
  }
  STEP(pB0,pB1,pA0,pA1,NT-1,false,false,false); RESC();
  { float sacc=pB0[0]+pB0[1]; _Pragma("unroll") for(int r=2;r<16;++r)sacc+=pB0[r]; _Pragma("unroll") for(int r=0;r<16;++r)sacc+=pB1[r]; l_reg+=sacc;
    pw0=(u32x4){PKW(pB0,0),PKW(pB0,2),PKW(pB0,4),PKW(pB0,6)};pw1=(u32x4){PKW(pB0,8),PKW(pB0,10),PKW(pB0,12),PKW(pB0,14)};pw2=(u32x4){PKW(pB1,0),PKW(pB1,2),PKW(pB1,4),PKW(pB1,6)};pw3=(u32x4){PKW(pB1,8),PKW(pB1,10),PKW(pB1,12),PKW(pB1,14)};
    SBAR(); pv(o,vb0+sl_cur,PAF(0),PAF(1),PAF(2),PAF(3)); }
  #undef PKW
  #undef PAF
  #undef VFR
  #undef PIN
  #undef MX3
  #undef GAPA
  #undef GAPB
  #undef EX
  #undef VRD
  #undef KRD
  #undef STEP
  #undef ENDW
  {auto rr=__builtin_amdgcn_permlane32_swap(__float_as_uint(l_reg),__float_as_uint(l_reg),false,false);l_reg=__uint_as_float(rr[0])+__uint_as_float(rr[1]);}
  if(hi==0)wsf[32+r32]=l_reg;asm volatile("s_waitcnt lgkmcnt(0)":::"memory");
  float rli[16];
  #pragma unroll
  for(int r=0;r<16;++r)rli[r]=__builtin_amdgcn_rcpf(wsf[32+crow(r,hi)]);
  bf16*Ow=Ow0+(long)wid*QBLK*OP; const bf16*Gw=Gw0+(long)wid*QBLK*QP;
  u32x4 gq[4];
  #pragma unroll
  for(int i=0;i<4;++i)gq[i]=*(const u32x4*)(Gw+(long)(i*8+(lane>>3))*QP+(lane&7)*8);
  { bf16*stg=(bf16*)(shm+LDS_OST)+wid*2048;
    #pragma unroll
    for(int r=0;r<16;++r){const int orow=crow(r,hi);
      #pragma unroll
      for(int d0=0;d0<2;++d0)stg[orow*64+d0*32+r32]=__float2bfloat16(o[d0][r]*rli[r]);}
    asm volatile("s_waitcnt lgkmcnt(0)":::"memory");
    #pragma unroll
    for(int i=0;i<4;++i){const int row=i*8+(lane>>3),ch=lane&7; const u32x4 v=*(const u32x4*)(stg+row*64+ch*8); const u32x4 g=gq[i]; u32x4 w;
      #pragma unroll
      for(int e=0;e<4;++e){ const float g0=__uint_as_float(g[e]<<16),g1=__uint_as_float(g[e]&0xffff0000u); const float v0=__uint_as_float(v[e]<<16),v1=__uint_as_float(v[e]&0xffff0000u);
        w[e]=cvtpk_s(v0*g0/(1.0f+__expf(-g0)),v1*g1/(1.0f+__expf(-g1))); }
      ATTN_STORE16(Ow+(long)row*OP+ch*8,w);} }
  asm volatile("s_waitcnt lgkmcnt(0)\n\ts_barrier":::"memory");
  #undef DMA_K
  #undef DMA_V
  #undef CMASK
  #undef START
  #undef RESC
  #undef ROT
}
constexpr int ATTN_LDS_BYTES=LDS_BYTES;

#undef SBAR
#undef WAIT_BAR
}

struct BRowPlain { const bf16_t* B; size_t ldb; __device__ __forceinline__ const bf16_t* operator()(int k) const { return B + (size_t)k * ldb; } };
struct BRowFFT1 { const bf16_t* B; size_t rs, ps; int n1mask, n1log; __device__ __forceinline__ const bf16_t* operator()(int k) const { return B + (size_t)(k & n1mask) * rs + (size_t)(k >> n1log) * ps; } };

struct NoBX { __device__ __forceinline__ void apply(u32x4 (&rb)[4], int tid) const {} };
struct BXSguNorm { const float* vg;
  __device__ __forceinline__ void apply(u32x4 (&rb)[4], int tid) const {
    float g[8];
#pragma unroll
    for (int e = 0; e < 8; ++e) g[e] = vg[(tid & 15) * 8 + e];
#pragma unroll
    for (int i = 0; i < 4; ++i) { float v[8];
#pragma unroll
      for (int e = 0; e < 4; ++e) { v[2 * e] = bf2f(rb[i][e] & 0xffffu); v[2 * e + 1] = bf2f(rb[i][e] >> 16); }
      float ss = 0.f;
#pragma unroll
      for (int e = 0; e < 8; ++e) ss += v[e] * v[e];
      ss += __shfl_xor(ss, 1); ss += __shfl_xor(ss, 2); ss += __shfl_xor(ss, 4); ss += __shfl_xor(ss, 8);
      const float rs = rsqrtf(ss * (1.0f / 128.0f) + EPS);
#pragma unroll
      for (int e = 0; e < 4; ++e) rb[i][e] = pk2(v[2 * e] * rs * g[2 * e], v[2 * e + 1] * rs * g[2 * e + 1]); }
  } };
template <int WM, int WN, int MI, int NI, bool BT, class BRow, class Epi, class BX = NoBX>
__device__ __forceinline__ void gemm_tile(LAS char* lds, const bf16_t* __restrict__ A, int lda, const BRow& brow, int K, const Epi& epi, const BX bx = BX()) {
  constexpr int BM = WM * MI * 32, BN = WN * NI * 32;
  static_assert(BN == 128 && WM * WN == 4, "tile config");
  constexpr int AP = 144, BP = 320, BOFF = BM * AP, ACH = BM * 8 / 256;
  const int tid = otid(), lane = tid & 63, wid = __builtin_amdgcn_readfirstlane(tid >> 6), wm = wid / WN, wn = wid % WN, r32 = lane & 31, hi = lane >> 5;
  u32x4 ra[ACH], rb[4];
  f32x16 acc[MI][NI];
#pragma unroll
  for (int mi = 0; mi < MI; ++mi)
#pragma unroll
    for (int ni = 0; ni < NI; ++ni)
#pragma unroll
      for (int r = 0; r < 16; ++r) acc[mi][ni][r] = 0.f;
#define GT_GLOAD(k0) do { \
    _Pragma("unroll") for (int i = 0; i < ACH; ++i) { const int c = tid + 256 * i; ra[i] = *(const u32x4*)(A + (size_t)(c >> 3) * lda + (k0) + (c & 7) * 8); } \
    _Pragma("unroll") for (int i = 0; i < 4; ++i) { const int c = tid + 256 * i; rb[i] = BT ? *(const u32x4*)(brow(c >> 3) + (k0) + (c & 7) * 8) : *(const u32x4*)(brow((k0) + (c >> 4)) + (c & 15) * 8); } } while (0)
#define GT_SSTORE() do { bx.apply(rb, tid); \
    _Pragma("unroll") for (int i = 0; i < ACH; ++i) { const int c = tid + 256 * i; *(LAS u32x4*)(lds + (c >> 3) * AP + (c & 7) * 16) = ra[i]; } \
    _Pragma("unroll") for (int i = 0; i < 4; ++i) { const int c = tid + 256 * i; *(LAS u32x4*)(lds + BOFF + (BT ? (c >> 3) * AP + (c & 7) * 16 : (c >> 4) * BP + (c & 15) * 16)) = rb[i]; } } while (0)
  GT_GLOAD(0); GT_SSTORE(); __syncthreads();
  const int nk = K >> 6;
  LAS char* abase = lds + (wm * MI * 32 + r32) * AP + hi * 16;
  LAS char* bbase = lds + BOFF + (8 * hi + ((lane & 15) >> 2)) * BP + (wn * NI * 32 + ((lane >> 4) & 1) * 16 + (lane & 3) * 4) * 2;
  LAS char* btbase = lds + BOFF + (wn * NI * 32 + r32) * AP + hi * 16;
  for (int kt = 0; kt < nk; ++kt) {
    if (kt + 1 < nk) GT_GLOAD((kt + 1) * 64);
#pragma unroll
    for (int kk = 0; kk < 4; ++kk) {
      bf16x8 af[MI], bfv[NI];
#pragma unroll
      for (int mi = 0; mi < MI; ++mi) af[mi] = *(LAS bf16x8*)(abase + mi * 32 * AP + kk * 32);
#pragma unroll
      for (int ni = 0; ni < NI; ++ni) {
        if (BT) bfv[ni] = *(LAS bf16x8*)(btbase + ni * 32 * AP + kk * 32);
        else { const s16x4 lo = tr16(bbase + kk * 16 * BP + ni * 64), h4 = tr16(bbase + (kk * 16 + 4) * BP + ni * 64);
          bfv[ni] = (bf16x8){lo[0], lo[1], lo[2], lo[3], h4[0], h4[1], h4[2], h4[3]}; } }
#pragma unroll
      for (int mi = 0; mi < MI; ++mi)
#pragma unroll
        for (int ni = 0; ni < NI; ++ni) acc[mi][ni] = __builtin_amdgcn_mfma_f32_32x32x16_bf16(af[mi], bfv[ni], acc[mi][ni], 0, 0, 0);
    }
    __syncthreads();
    if (kt + 1 < nk) { GT_SSTORE(); __syncthreads(); }
  }
#undef GT_GLOAD
#undef GT_SSTORE
  if constexpr (Epi::STAGED) {
    const int rb = wm * MI * 32, cb = wn * NI * 32;
    constexpr int SP = NI * 64 + 16, CPR = NI * 4, RPP = 64 / CPR, NP = MI * 32 / RPP;
    typename Epi::Ops ops[NP];
#pragma unroll
    for (int ps = 0; ps < NP; ++ps) ops[ps] = epi.load(rb + ps * RPP + lane / CPR, cb + (lane % CPR) * 8);
    epi.pre(acc, rb, cb, r32, hi);
    LAS char* st = lds + wid * (MI * 32 * SP);
#pragma unroll
    for (int mi = 0; mi < MI; ++mi)
#pragma unroll
      for (int ni = 0; ni < NI; ++ni)
#pragma unroll
        for (int r = 0; r < 16; ++r) *(LAS bf16_t*)(st + (mi * 32 + crow(r, hi)) * SP + (ni * 32 + r32) * 2) = (bf16_t)f2bf(acc[mi][ni][r]);
    asm volatile("s_waitcnt lgkmcnt(0)" ::: "memory");
#pragma unroll
    for (int ps = 0; ps < NP; ++ps) { const int row = ps * RPP + lane / CPR, chk = lane % CPR;
      const u32x4 v = *(LAS u32x4*)(st + row * SP + chk * 16); epi.fin(rb + row, cb + chk * 8, v, ops[ps]); }
    __syncthreads();
  } else epi(acc, wm * MI * 32, wn * NI * 32, r32, hi);
}

__device__ __forceinline__ float silu_f(float x) { return x / (1.0f + __expf(-x)); }
__device__ __forceinline__ u32x4 mul_silu8(const u32x4 v, const u32x4 g) { u32x4 w;
#pragma unroll
  for (int e = 0; e < 4; ++e) { const float g0 = bf2f(g[e] & 0xffffu), g1 = bf2f(g[e] >> 16); w[e] = pk2(bf2f(v[e] & 0xffffu) * silu_f(g0), bf2f(v[e] >> 16) * silu_f(g1)); }
  return w; }
struct EpiStoreBf16 { bf16_t* C; size_t ldc; static constexpr bool STAGED = true;
  template <int MI, int NI> __device__ __forceinline__ void pre(f32x16 (&acc)[MI][NI], int rb, int cb, int r32, int hi) const {}
  struct Ops {};
  __device__ __forceinline__ Ops load(int row, int col) const { return Ops{}; }
  __device__ __forceinline__ void fin(int row, int col, const u32x4 v, const Ops&) const { *(u32x4*)(C + (size_t)row * ldc + col) = v; } };
struct EpiStoreBf16T { bf16_t* CT; size_t ldt; static constexpr bool STAGED = false;
  template <int MI, int NI> __device__ __forceinline__ void operator()(const f32x16 (&acc)[MI][NI], int rb, int cb, int r32, int hi) const {
#pragma unroll
    for (int mi = 0; mi < MI; ++mi)
#pragma unroll
      for (int ni = 0; ni < NI; ++ni)
#pragma unroll
        for (int g = 0; g < 4; ++g) { u32x2 w; w[0] = pk2(acc[mi][ni][4 * g], acc[mi][ni][4 * g + 1]); w[1] = pk2(acc[mi][ni][4 * g + 2], acc[mi][ni][4 * g + 3]);
          *(u32x2*)(CT + (size_t)(cb + ni * 32 + r32) * ldt + rb + mi * 32 + 8 * g + 4 * hi) = w; }
  } };
struct EpiFFT1 { bf16_t* TBb; const float* tw; int k1base, s2, N2; static constexpr bool STAGED = true;
  template <int MI, int NI> __device__ __forceinline__ void pre(f32x16 (&acc)[MI][NI], int rb, int cb, int r32, int hi) const {
    static_assert(MI == 2 && NI == 1, "fft1 cfg");
#pragma unroll
    for (int r = 0; r < 16; ++r) { const int k1 = k1base + crow(r, hi); const float co = tw[2 * (k1 * s2)], si = tw[2 * (k1 * s2) + 1];
      const float tr = acc[0][0][r], ti = acc[1][0][r];
      acc[0][0][r] = tr * co + ti * si; acc[1][0][r] = ti * co - tr * si; }
  }
  struct Ops {};
  __device__ __forceinline__ Ops load(int row, int col) const { return Ops{}; }
  __device__ __forceinline__ void fin(int row, int col, const u32x4 v, const Ops&) const { const int part = row >> 5, k1 = k1base + (row & 31);
    *(u32x4*)(TBb + ((size_t)(k1 * 2 + part) * N2 + s2) * 512 + col) = v; } };
struct EpiFFT3 { bf16_t* Ob; const bf16_t* Gb; int k2base, N1; static constexpr bool STAGED = true;
  template <int MI, int NI> __device__ __forceinline__ void pre(f32x16 (&acc)[MI][NI], int rb, int cb, int r32, int hi) const {}
  struct Ops { u32x4 g; };
  __device__ __forceinline__ Ops load(int row, int col) const { const size_t t = (size_t)(k2base + row) * N1; return Ops{*(const u32x4*)(Gb + t * ZP_ + col)}; }
  __device__ __forceinline__ void fin(int row, int col, const u32x4 v, const Ops& o) const { const size_t t = (size_t)(k2base + row) * N1;
    *(u32x4*)(Ob + t * DMIX + col) = mul_silu8(v, o.g); } };
struct EpiSGU { bf16_t* Ob; const bf16_t* Ub; const bf16_t* Gb; const float* bias; static constexpr bool STAGED = true;
  template <int MI, int NI> __device__ __forceinline__ void pre(f32x16 (&acc)[MI][NI], int rb, int cb, int r32, int hi) const {
#pragma unroll
    for (int mi = 0; mi < MI; ++mi)
#pragma unroll
      for (int r = 0; r < 16; ++r) { const float bv = bias[rb + mi * 32 + crow(r, hi)];
#pragma unroll
        for (int ni = 0; ni < NI; ++ni) acc[mi][ni][r] += bv; }
  }
  struct Ops { u32x4 u, g; };
  __device__ __forceinline__ Ops load(int row, int col) const { return Ops{*(const u32x4*)(Ub + (size_t)row * ZP_ + col), *(const u32x4*)(Gb + (size_t)row * ZP_ + col)}; }
  __device__ __forceinline__ void fin(int row, int col, const u32x4 v, const Ops& o) const {
    const u32x4 u = o.u, g = o.g; u32x4 w;
#pragma unroll
    for (int e = 0; e < 4; ++e) { const float g0 = bf2f(g[e] & 0xffffu), g1 = bf2f(g[e] >> 16);
      w[e] = pk2(bf2f(v[e] & 0xffffu) * bf2f(u[e] & 0xffffu) * silu_f(g0), bf2f(v[e] >> 16) * bf2f(u[e] >> 16) * silu_f(g1)); }
    *(u32x4*)(Ob + (size_t)row * DMIX + col) = w; } };


template <class BRow, class Epi>
__device__ __forceinline__ void gemm_tile_dual(LAS char* lds, const bf16_t* __restrict__ A0, const bf16_t* __restrict__ A1, int lda, const BRow& br0, const BRow& br1, int K, const Epi& ep0, const Epi& ep1) {
  constexpr int MI = 2, NI = 1, BM = 64, AP = 144, BP = 320, BOFF = BM * AP, USZ = BOFF + 64 * BP, ACH = 2;
  static_assert(2 * USZ <= LDS_HALF, "dual tile LDS");
  const int tid = otid(), lane = tid & 63, wid = __builtin_amdgcn_readfirstlane(tid >> 6), wn = wid, r32 = lane & 31, hi = lane >> 5;
  u32x4 ra[2][ACH], rb[2][4];
  f32x16 acc[2][MI][NI];
#pragma unroll
  for (int d = 0; d < 2; ++d)
#pragma unroll
    for (int mi = 0; mi < MI; ++mi)
#pragma unroll
      for (int r = 0; r < 16; ++r) acc[d][mi][0][r] = 0.f;
#define GD_GLOAD(k0) do { _Pragma("unroll") for (int d = 0; d < 2; ++d) { const bf16_t* Ad = d ? A1 : A0; \
    _Pragma("unroll") for (int i = 0; i < ACH; ++i) { const int c = tid + 256 * i; ra[d][i] = *(const u32x4*)(Ad + (size_t)(c >> 3) * lda + (k0) + (c & 7) * 8); } \
    _Pragma("unroll") for (int i = 0; i < 4; ++i) { const int c = tid + 256 * i; rb[d][i] = *(const u32x4*)((d ? br1((k0) + (c >> 4)) : br0((k0) + (c >> 4))) + (c & 15) * 8); } } } while (0)
#define GD_SSTORE() do { _Pragma("unroll") for (int d = 0; d < 2; ++d) { \
    _Pragma("unroll") for (int i = 0; i < ACH; ++i) { const int c = tid + 256 * i; *(LAS u32x4*)(lds + d * USZ + (c >> 3) * AP + (c & 7) * 16) = ra[d][i]; } \
    _Pragma("unroll") for (int i = 0; i < 4; ++i) { const int c = tid + 256 * i; *(LAS u32x4*)(lds + d * USZ + BOFF + (c >> 4) * BP + (c & 15) * 16) = rb[d][i]; } } } while (0)
  GD_GLOAD(0); GD_SSTORE(); __syncthreads();
  const int nk = K >> 6;
  LAS char* abase = lds + r32 * AP + hi * 16;
  LAS char* bbase = lds + BOFF + (8 * hi + ((lane & 15) >> 2)) * BP + (wn * 32 + ((lane >> 4) & 1) * 16 + (lane & 3) * 4) * 2;
  for (int kt = 0; kt < nk; ++kt) {
    if (kt + 1 < nk) GD_GLOAD((kt + 1) * 64);
#pragma unroll
    for (int kk = 0; kk < 4; ++kk) {
#pragma unroll
      for (int d = 0; d < 2; ++d) {
        const bf16x8 a0 = *(LAS bf16x8*)(abase + d * USZ + kk * 32), a1 = *(LAS bf16x8*)(abase + d * USZ + 32 * AP + kk * 32);
        const s16x4 lo = tr16(bbase + d * USZ + kk * 16 * BP), h4 = tr16(bbase + d * USZ + (kk * 16 + 4) * BP);
        const bf16x8 bv = (bf16x8){lo[0], lo[1], lo[2], lo[3], h4[0], h4[1], h4[2], h4[3]};
        acc[d][0][0] = __builtin_amdgcn_mfma_f32_32x32x16_bf16(a0, bv, acc[d][0][0], 0, 0, 0);
        acc[d][1][0] = __builtin_amdgcn_mfma_f32_32x32x16_bf16(a1, bv, acc[d][1][0], 0, 0, 0);
      }
    }
    __syncthreads();
    if (kt + 1 < nk) { GD_SSTORE(); __syncthreads(); }
  }
#undef GD_GLOAD
#undef GD_SSTORE
  constexpr int SP = NI * 64 + 16, CPR = NI * 4, RPP = 64 / CPR, NP = MI * 32 / RPP;
  const int cb = wn * 32;
  typename Epi::Ops ops[2][NP];
#pragma unroll
  for (int ps = 0; ps < NP; ++ps) { ops[0][ps] = ep0.load(ps * RPP + lane / CPR, cb + (lane % CPR) * 8); ops[1][ps] = ep1.load(ps * RPP + lane / CPR, cb + (lane % CPR) * 8); }
  LAS char* st = lds + wid * (MI * 32 * SP);
#pragma unroll
  for (int d = 0; d < 2; ++d) {
    if (d == 0) ep0.pre(acc[0], 0, cb, r32, hi); else ep1.pre(acc[1], 0, cb, r32, hi);
#pragma unroll
    for (int mi = 0; mi < MI; ++mi)
#pragma unroll
      for (int r = 0; r < 16; ++r) *(LAS bf16_t*)(st + (mi * 32 + crow(r, hi)) * SP + r32 * 2) = (bf16_t)f2bf(acc[d][mi][0][r]);
    asm volatile("s_waitcnt lgkmcnt(0)" ::: "memory");
#pragma unroll
    for (int ps = 0; ps < NP; ++ps) { const int row = ps * RPP + lane / CPR, chk = lane % CPR;
      const u32x4 v = *(LAS u32x4*)(st + row * SP + chk * 16);
      if (d == 0) ep0.fin(row, cb + chk * 8, v, ops[0][ps]); else ep1.fin(row, cb + chk * 8, v, ops[1][ps]); }
    asm volatile("s_waitcnt lgkmcnt(0)" ::: "memory");
  }
  __syncthreads();
}

template <int D, bool PF, int NWV>
__device__ __forceinline__ void attn_unit(LAS char* lds, const bf16_t* Qw, size_t ldq, const bf16_t* Kp, size_t ldk, const bf16_t* Vp, size_t ldv, int nkeys, float c,
                                          const bf16_t* Gw, size_t ldg, bf16_t* Ow, size_t ldo) {
  constexpr int NTH = NWV * 64, ND = D / 16, NB = D / 32, KP = D * 2 + 16, VP = (D == 64 ? 192 : 320), V_OFF = 64 * KP, CH = 64 * (D / 8) / NTH, RCH = D / 8;
  constexpr int W_OFF = (V_OFF + 64 * VP) > NWV * 32 * (D * 2 + 16) ? (V_OFF + 64 * VP) : NWV * 32 * (D * 2 + 16);
  int tid_ = NWV == 8 ? (int)threadIdx.x : (int)(threadIdx.x & 255); asm volatile("" : "+v"(tid_));
  const int tid = tid_, lane = tid & 63, wid = __builtin_amdgcn_readfirstlane(tid >> 6), r32 = lane & 31, hi = lane >> 5;
  bf16x8 qr[ND];
#pragma unroll
  for (int d0 = 0; d0 < ND; ++d0) qr[d0] = *(const bf16x8*)(Qw + (size_t)r32 * ldq + d0 * 16 + hi * 8);
  f32x16 o[NB];
#pragma unroll
  for (int nb = 0; nb < NB; ++nb)
#pragma unroll
    for (int r = 0; r < 16; ++r) o[nb][r] = 0.f;
  float m = -1e30f, l = 0.f;
  u32x4 rk[CH], rv[CH];
  LAS float* wsf = (LAS float*)(lds + W_OFF + wid * 128);
#define AT_GLOAD(t) do { _Pragma("unroll") for (int i = 0; i < CH; ++i) { const int cc = tid + NTH * i; const size_t row = (size_t)(t) * 64 + cc / RCH; const int ch = cc % RCH; \
      rk[i] = *(const u32x4*)(Kp + row * ldk + ch * 8); rv[i] = *(const u32x4*)(Vp + row * ldv + ch * 8); } } while (0)
#define AT_SSTORE() do { _Pragma("unroll") for (int i = 0; i < CH; ++i) { const int cc = tid + NTH * i; const int row = cc / RCH, ch = cc % RCH; \
      *(LAS u32x4*)(lds + row * KP + ch * 16) = rk[i]; *(LAS u32x4*)(lds + V_OFF + row * VP + ch * 16) = rv[i]; } } while (0)
  const int nt = nkeys >> 6;
  AT_GLOAD(0); AT_SSTORE(); __syncthreads();
  LAS char* kb = lds + r32 * KP + hi * 16;
  LAS char* vb = lds + V_OFF + (4 * hi + ((lane & 15) >> 2)) * VP + (((lane >> 4) & 1) * 16 + (lane & 3) * 4) * 2;
  for (int t = 0; t < nt; ++t) {
    if (PF && t + 1 < nt) AT_GLOAD(t + 1);
    f32x16 p0, p1;
#pragma unroll
    for (int r = 0; r < 16; ++r) { p0[r] = 0.f; p1[r] = 0.f; }
#pragma unroll
    for (int d0 = 0; d0 < ND; ++d0) {
      const bf16x8 k0 = *(LAS bf16x8*)(kb + d0 * 32), k1 = *(LAS bf16x8*)(kb + 32 * KP + d0 * 32);
      p0 = __builtin_amdgcn_mfma_f32_32x32x16_bf16(k0, qr[d0], p0, 0, 0, 0);
      p1 = __builtin_amdgcn_mfma_f32_32x32x16_bf16(k1, qr[d0], p1, 0, 0, 0);
    }
    float mx = p0[0];
#pragma unroll
    for (int r = 1; r < 16; ++r) mx = fmaxf(mx, p0[r]);
#pragma unroll
    for (int r = 0; r < 16; ++r) mx = fmaxf(mx, p1[r]);
    mx = fmaxf(mx, __shfl_xor(mx, 32));
    if (__any(mx > m)) {
      const float mn = fmaxf(m, mx), alpha = __builtin_amdgcn_exp2f((m - mn) * c); m = mn; l *= alpha;
      if (hi == 0) wsf[r32] = alpha;
      asm volatile("s_waitcnt lgkmcnt(0)" ::: "memory");
#pragma unroll
      for (int g = 0; g < 4; ++g) { const f32x4 a4 = *(LAS f32x4*)(wsf + 8 * g + 4 * hi);
#pragma unroll
        for (int nb = 0; nb < NB; ++nb)
#pragma unroll
          for (int i = 0; i < 4; ++i) o[nb][4 * g + i] *= a4[i]; }
      asm volatile("s_waitcnt lgkmcnt(0)" ::: "memory");
    }
    const float mc = m * c;
    float rs = 0.f;
#pragma unroll
    for (int r = 0; r < 16; ++r) { p0[r] = __builtin_amdgcn_exp2f(p0[r] * c - mc); rs += p0[r]; }
#pragma unroll
    for (int r = 0; r < 16; ++r) { p1[r] = __builtin_amdgcn_exp2f(p1[r] * c - mc); rs += p1[r]; }
    l += rs;
    bf16x8 pa[4];
#pragma unroll
    for (int s = 0; s < 2; ++s) {
      u32x4 w0, w1;
      w0[0] = pk2(p0[8 * s + 0], p0[8 * s + 1]); w0[1] = pk2(p0[8 * s + 2], p0[8 * s + 3]); w0[2] = pk2(p0[8 * s + 4], p0[8 * s + 5]); w0[3] = pk2(p0[8 * s + 6], p0[8 * s + 7]);
      w1[0] = pk2(p1[8 * s + 0], p1[8 * s + 1]); w1[1] = pk2(p1[8 * s + 2], p1[8 * s + 3]); w1[2] = pk2(p1[8 * s + 4], p1[8 * s + 5]); w1[3] = pk2(p1[8 * s + 6], p1[8 * s + 7]);
      pa[s] = __builtin_bit_cast(bf16x8, w0); pa[2 + s] = __builtin_bit_cast(bf16x8, w1);
    }
#pragma unroll
    for (int nb = 0; nb < NB; ++nb)
#pragma unroll
      for (int s = 0; s < 4; ++s) {
        const s16x4 lo = tr16(vb + (16 * s) * VP + nb * 64), h4 = tr16(vb + (16 * s + 8) * VP + nb * 64);
        const bf16x8 vf = (bf16x8){lo[0], lo[1], lo[2], lo[3], h4[0], h4[1], h4[2], h4[3]};
        o[nb] = __builtin_amdgcn_mfma_f32_32x32x16_bf16(pa[s], vf, o[nb], 0, 0, 0);
      }
    __syncthreads();
    if (t + 1 < nt) { if (!PF) AT_GLOAD(t + 1); AT_SSTORE(); __syncthreads(); }
  }
#undef AT_GLOAD
#undef AT_SSTORE
  l += __shfl_xor(l, 32);
  if (hi == 0) wsf[r32] = 1.0f / l;
  asm volatile("s_waitcnt lgkmcnt(0)" ::: "memory");
  constexpr int SP = D * 2 + 16, CPR = D / 8, RPP = 64 / CPR, NP = 32 / RPP;
  u32x4 gts[NP];
#pragma unroll
  for (int ps = 0; ps < NP; ++ps) gts[ps] = *(const u32x4*)(Gw + (size_t)(ps * RPP + lane / CPR) * ldg + (lane % CPR) * 8);
  LAS char* st = lds + wid * (32 * SP);
#pragma unroll
  for (int g = 0; g < 4; ++g) { const f32x4 a4 = *(LAS f32x4*)(wsf + 8 * g + 4 * hi);
#pragma unroll
    for (int i = 0; i < 4; ++i)
#pragma unroll
      for (int nb = 0; nb < NB; ++nb) *(LAS bf16_t*)(st + (8 * g + 4 * hi + i) * SP + (nb * 32 + r32) * 2) = (bf16_t)f2bf(o[nb][4 * g + i] * a4[i]); }
  asm volatile("s_waitcnt lgkmcnt(0)" ::: "memory");
#pragma unroll
  for (int ps = 0; ps < NP; ++ps) { const int row = ps * RPP + lane / CPR, chk = lane % CPR;
    const u32x4 v = *(LAS u32x4*)(st + row * SP + chk * 16);
    *(u32x4*)(Ow + (size_t)row * ldo + chk * 8) = mul_silu8(v, gts[ps]); }
  __syncthreads();
}

__device__ __forceinline__ void row_norm_bf16(const float* x, const float* g, bf16_t* out, int lane) {
  f32x4 v[4]; float ss = 0.f;
#pragma unroll
  for (int i = 0; i < 4; ++i) { v[i] = *(const f32x4*)(x + lane * 4 + i * 256); ss += v[i][0] * v[i][0] + v[i][1] * v[i][1] + v[i][2] * v[i][2] + v[i][3] * v[i][3]; }
  ss = wave_sum(ss); const float rs = rsqrtf(ss * (1.0f / 1024.0f) + EPS);
#pragma unroll
  for (int i = 0; i < 4; ++i) { f32x4 gg = {1.f, 1.f, 1.f, 1.f}; if (g) gg = *(const f32x4*)(g + lane * 4 + i * 256);
    u32x2 w; w[0] = pk2(v[i][0] * rs * gg[0], v[i][1] * rs * gg[1]); w[1] = pk2(v[i][2] * rs * gg[2], v[i][3] * rs * gg[3]);
    *(u32x2*)(out + lane * 4 + i * 256) = w; }
}

__device__ __forceinline__ void unpack8(const u32x4 w, float* v) {
#pragma unroll
  for (int i = 0; i < 4; ++i) { v[2 * i] = bf2f(w[i] & 0xffffu); v[2 * i + 1] = bf2f(w[i] >> 16); }
}
__device__ __forceinline__ u32x4 pack8(const float* v) { u32x4 w;
#pragma unroll
  for (int i = 0; i < 4; ++i) w[i] = pk2(v[2 * i], v[2 * i + 1]); return w; }

__device__ __forceinline__ void head_norm_rope(bf16_t* ptr, const float* gain  , const float* rope  , int lane, float osc) {
  const u32x4 w = *(const u32x4*)ptr; float v[8]; unpack8(w, v);
  float ss = 0.f;
#pragma unroll
  for (int e = 0; e < 8; ++e) ss += v[e] * v[e];
  ss += __shfl_xor(ss, 1); ss += __shfl_xor(ss, 2); ss += __shfl_xor(ss, 4);
  const float rs = rsqrtf(ss * (1.0f / 64.0f) + EPS);
  const int sub = lane & 7, a = sub >> 2, isx2 = (sub >> 1) & 1, p0 = (sub & 1) * 8;
  float o[8];
#pragma unroll
  for (int e = 0; e < 8; ++e) v[e] = v[e] * rs * gain[sub * 8 + e];
#pragma unroll
  for (int e = 0; e < 8; ++e) { const float pv = __shfl_xor(v[e], 2); const float co = rope[a * 16 + p0 + e], si = rope[32 + a * 16 + p0 + e];
    o[e] = (v[e] * co + (isx2 ? pv : -pv) * si) * osc; }
  *(u32x4*)ptr = pack8(o);
}

struct Ctx {
  const float* x_prompt; const float* x_sample; const float* mem_prompt; const float* mem_sample; const float* pre_g; const float* w_in; const float* q_g; const float* k_g;
  const float* w_f; const float* v_g; const float* w_s; const float* b_s; const float* mem_g; const float* w_mkv; const float* w_out; const float* post_g;
  float* out; char* ws;
  __device__ __forceinline__ bf16_t* XB() const { return (bf16_t*)(ws + OFF_XB); }
  __device__ __forceinline__ bf16_t* O() const { return (bf16_t*)(ws + OFF_O); }
  __device__ __forceinline__ bf16_t* Z() const { return (bf16_t*)(ws + OFF_ZY); }
  __device__ __forceinline__ bf16_t* ZB() const { return (bf16_t*)out; }
  __device__ __forceinline__ float* Y() const { return (float*)(ws + OFF_ZY); }
  __device__ __forceinline__ bf16_t* TB() const { return (bf16_t*)(ws + OFF_TB); }
  __device__ __forceinline__ bf16_t* WIN() const { return (bf16_t*)(ws + OFF_WIN); }
  __device__ __forceinline__ bf16_t* WFA() const { return (bf16_t*)(ws + OFF_WFA); }
  __device__ __forceinline__ bf16_t* WOUT() const { return (bf16_t*)(ws + OFF_WOUT); }
  __device__ __forceinline__ bf16_t* WMKV() const { return (bf16_t*)(ws + OFF_WMKV); }
  __device__ __forceinline__ bf16_t* MEMN() const { return (bf16_t*)(ws + OFF_MEMN); }
  __device__ __forceinline__ bf16_t* MKV() const { return (bf16_t*)(ws + OFF_MKV); }
  __device__ __forceinline__ bf16_t* WCS() const { return (bf16_t*)(ws + OFF_WCS); }
  __device__ __forceinline__ bf16_t* WSB() const { return (bf16_t*)(ws + OFF_WSB); }
  __device__ __forceinline__ bf16_t* A1_64() const { return (bf16_t*)(ws + OFF_A1_64); }
  __device__ __forceinline__ bf16_t* A1_128() const { return (bf16_t*)(ws + OFF_A1_128); }
  __device__ __forceinline__ bf16_t* A3_64() const { return (bf16_t*)(ws + OFF_A3_64); }
  __device__ __forceinline__ bf16_t* A3_128() const { return (bf16_t*)(ws + OFF_A3_128); }
  __device__ __forceinline__ float* TW8192() const { return (float*)(ws + OFF_TW8192); }
  __device__ __forceinline__ float* TW2048() const { return (float*)(ws + OFF_TW2048); }
  __device__ __forceinline__ float* ROPE() const { return (float*)(ws + OFF_ROPE); }
};

__device__ __forceinline__ bf16_t* zp(const Ctx& c, int si, size_t row, int col) { const int blk = col >> 7;
  bf16_t* base = blk < ZBLKA ? c.Z() : c.ZB(); return base + ((size_t)(blk < ZBLKA ? blk : blk - ZBLKA) * ZROWS + (size_t)si * CH_TOK + row) * 128 + (col & 127); }

__device__ __forceinline__ void phase_prep_a(const Ctx& c, LAS char* lds) {
  const int tid = otid(), lane = tid & 63, wid = tid >> 6;
  const int gw = vblk() * 4 + wid, nw = vgrid() * 4;
  const size_t gt = (size_t)vblk() * 256 + tid, gs = (size_t)vgrid() * 256;
  LAS float* ctab = (LAS float*)(lds + LDS_TAB); LAS float* stab = ctab + 128;
  for (int row = gw; row < NTOK; row += 2 * nw) {
    const int row2 = row + nw < NTOK ? row + nw : row;
    const float* x = row < NPROMPT_TOK ? c.x_prompt + (size_t)row * DM : c.x_sample + (size_t)(row - NPROMPT_TOK) * DM;
    const float* x2 = row2 < NPROMPT_TOK ? c.x_prompt + (size_t)row2 * DM : c.x_sample + (size_t)(row2 - NPROMPT_TOK) * DM;
    f32x4 v[2][4]; float ss0 = 0.f, ss1 = 0.f;
#pragma unroll
    for (int i = 0; i < 4; ++i) { v[0][i] = *(const f32x4*)(x + lane * 4 + i * 256); v[1][i] = *(const f32x4*)(x2 + lane * 4 + i * 256); }
#pragma unroll
    for (int i = 0; i < 4; ++i) { ss0 += v[0][i][0] * v[0][i][0] + v[0][i][1] * v[0][i][1] + v[0][i][2] * v[0][i][2] + v[0][i][3] * v[0][i][3];
      ss1 += v[1][i][0] * v[1][i][0] + v[1][i][1] * v[1][i][1] + v[1][i][2] * v[1][i][2] + v[1][i][3] * v[1][i][3]; }
    ss0 = wave_sum(ss0); ss1 = wave_sum(ss1);
    const float ms0 = ss0 * (1.0f / 1024.0f) + EPS, ms1 = ss1 * (1.0f / 1024.0f) + EPS; const float rs0 = rsqrtf(ms0), rs1 = rsqrtf(ms1);
    if (lane == 0) { float* rsa = (float*)(c.ws + OFF_RS2); rsa[row] = ms0 * rs0; rsa[row2] = ms1 * rs1; }
#pragma unroll
    for (int i = 0; i < 4; ++i) { const f32x4 gg = {1.f, 1.f, 1.f, 1.f};
      u32x2 w; w[0] = pk2(v[0][i][0] * rs0 * gg[0], v[0][i][1] * rs0 * gg[1]); w[1] = pk2(v[0][i][2] * rs0 * gg[2], v[0][i][3] * rs0 * gg[3]);
      *(u32x2*)(c.XB() + (size_t)row * DM + lane * 4 + i * 256) = w;
      u32x2 w2; w2[0] = pk2(v[1][i][0] * rs1 * gg[0], v[1][i][1] * rs1 * gg[1]); w2[1] = pk2(v[1][i][2] * rs1 * gg[2], v[1][i][3] * rs1 * gg[3]);
      *(u32x2*)(c.XB() + (size_t)row2 * DM + lane * 4 + i * 256) = w2; }
  }
  for (int row = gw; row < NMEMROWS; row += nw) {
    const float* x = row < 512 ? c.mem_prompt + (size_t)row * DM : c.mem_sample + (size_t)(row - 512) * DM;
    row_norm_bf16(x, nullptr, c.MEMN() + (size_t)row * DM, lane);
  }
  { LAS float* scr = (LAS float*)(vlds(lds) + wid * 8448);
    const int n_in = 2 * 16 * 152, n_out = 2 * 32 * 32, n_mkv = 2 * 16 * 32;
    for (int it = gw; it < n_in + n_out + n_mkv; it += nw) {
      const float* W; int N, k0, n0, Kd; bf16_t* WT; bool plain = false; int l; const float* kgain = nullptr;
      if (it < n_in) { l = it / (16 * 152); const int r = it % (16 * 152); k0 = (r / 152) * 64; n0 = (r % 152) * 32; W = c.w_in + (size_t)l * 1024 * 4864; N = 4864; Kd = 1024; kgain = c.pre_g + l * 1024;
        plain = (n0 >= 1280 && n0 < 1792); const int nr = n0 < 1280 ? n0 : n0 + 512; WT = c.WIN() + ((size_t)l * NZ + nr) * 1024; }
      else if (it < n_in + n_out) { const int r0 = it - n_in; l = r0 / 1024; const int r = r0 % 1024; k0 = (r / 32) * 64; n0 = (r % 32) * 32; W = c.w_out + (size_t)l * 2048 * 1024; N = 1024; Kd = 2048; WT = c.WOUT() + ((size_t)l * 1024 + n0) * 2048; }
      else { const int r0 = it - n_in - n_out; l = r0 / 512; const int r = r0 % 512; k0 = (r / 32) * 64; n0 = (r % 32) * 32; W = c.w_mkv + (size_t)l * 1024 * 1024; N = 1024; Kd = 1024; WT = c.WMKV() + ((size_t)l * 1024 + n0) * 1024; kgain = c.mem_g + l * 1024; }
      if (plain) {
#pragma unroll 8
        for (int i = 0; i < 32; ++i) { const int kk = 2 * i + (lane >> 5); c.WFA()[((size_t)l * 1024 + k0 + kk) * 512 + (n0 - 1280) + (lane & 31)] = (bf16_t)f2bf(W[(size_t)(k0 + kk) * N + n0 + (lane & 31)] * kgain[k0 + kk]); }
      } else {
#pragma unroll 8
        for (int i = 0; i < 32; ++i) { const int kk = 2 * i + (lane >> 5); scr[kk * 33 + (lane & 31)] = W[(size_t)(k0 + kk) * N + n0 + (lane & 31)]; }
        asm volatile("s_waitcnt lgkmcnt(0)" ::: "memory");
        const int cch = lane & 7;
#pragma unroll
        for (int j = 0; j < 4; ++j) { const int n = (lane >> 3) + 8 * j; const LAS float* sp = scr + (8 * cch) * 33 + n;
          float gk[8];
#pragma unroll
          for (int e = 0; e < 8; ++e) gk[e] = kgain ? kgain[k0 + 8 * cch + e] : 1.0f;
          u32x4 o; o[0] = pk2(sp[0] * gk[0], sp[33] * gk[1]); o[1] = pk2(sp[2 * 33] * gk[2], sp[3 * 33] * gk[3]); o[2] = pk2(sp[4 * 33] * gk[4], sp[5 * 33] * gk[5]); o[3] = pk2(sp[6 * 33] * gk[6], sp[7 * 33] * gk[7]);
          *(u32x4*)(WT + (size_t)n * Kd + k0 + 8 * cch) = o; }
        asm volatile("s_waitcnt lgkmcnt(0)" ::: "memory");
      }
    }
  }
  for (size_t i = gt; i < (size_t)32768; i += gs) { const f32x4 v = *(const f32x4*)(c.w_s + i * 4); u32x2 w; w[0] = pk2(v[0], v[1]); w[1] = pk2(v[2], v[3]); *(u32x2*)(c.WSB() + i * 4) = w; }
  for (size_t i = gt; i < (size_t)262144; i += gs) {
    const int n = (int)(i & 255), cp = (int)((i >> 8) & 127), lg = (int)(i >> 15); const int d = n & 127; const bool is_sin = n >= 128;
    const float* wf = c.w_f + (size_t)lg * 16384 + d; float s = 0.f;
#pragma unroll 16
    for (int kc = 0; kc < 128; ++kc) { const int j = (kc * cp) & 127; s += (is_sin ? stab[j] : ctab[j]) * wf[kc * 128]; }
    c.WCS()[i] = (bf16_t)f2bf(s * 0.08838834764831845f);
  }
  for (size_t i = gt; i < (size_t)(4096 + 16384); i += gs) {
    const bool big = i >= 4096; const int idx = big ? (int)i - 4096 : (int)i; const int N1 = big ? 64 : 32, W = 2 * N1;
    const int rho = idx / W, kap = idx % W; const int part = (rho & 63) >> 5, k1 = (rho >> 6) * 32 + (rho & 31), pin = kap / N1, s1 = kap % N1;
    float sn, cs; sincospif(2.0f * (float)((k1 * s1) % N1) / (float)N1, &sn, &cs);
    const float sc = rsqrtf((float)N1); float v = (part == pin) ? cs : -sn; if (part == 1 && pin == 1) v = -cs;
    (big ? c.A1_128() : c.A1_64())[idx] = (bf16_t)f2bf(v * sc);
  }
  for (size_t i = gt; i < (size_t)(8192 + 32768); i += gs) {
    const bool big = i >= 8192; const int idx = big ? (int)i - 8192 : (int)i; const int N2 = big ? 128 : 64, W = 2 * N2;
    const int k2 = idx / W, kap = idx % W, pin = kap / N2, s2 = kap % N2;
    float sn, cs; sincospif(2.0f * (float)((k2 * s2) % N2) / (float)N2, &sn, &cs);
    (big ? c.A3_128() : c.A3_64())[idx] = (bf16_t)f2bf((pin ? sn : cs) * rsqrtf((float)N2));
  }
  for (size_t i = gt; i < (size_t)(8192 + 2048); i += gs) {
    const bool small = i >= 8192; const int j = small ? (int)i - 8192 : (int)i; const int S = small ? 2048 : 8192;
    float sn, cs; sincospif(2.0f * (float)j / (float)S, &sn, &cs);
    float* d = (small ? c.TW2048() : c.TW8192()) + 2 * j; d[0] = cs; d[1] = sn;
  }
  for (size_t i = gt; i < (size_t)8192 * 32; i += gs) {
    const int t = (int)(i >> 5), ap = (int)(i & 31), a = ap >> 4, p = ap & 15;
    const float inv = powf(10000.0f, -(float)p / 16.0f); const float pos = (float)(a == 0 ? (t >> 6) : (t & 63)); const float ang = pos * inv;
    float sn, cs; sincosf(ang, &sn, &cs);
    c.ROPE()[(size_t)t * 64 + ap] = cs; c.ROPE()[(size_t)t * 64 + 32 + ap] = sn;
  }
}

__device__ __forceinline__ void phase_prep_b(const Ctx& c, LAS char* lds) {
  { pg8::Gemm g{c.MEMN(), c.WMKV(), NMEMROWS, 1024, DM}; pg8::StaticOrder S; S.init(NMEMROWS, 1024, (int)gridDim.x, (int)blockIdx.x);
    pg8::EpiBf16 E{c.MKV(), 2048};
    pg8::gemm_phase<pg8::EpiBf16, pg8::StaticOrder, true, true>((PG8_LAS unsigned char*)lds, g, S, E); }
  LAS char* vl = vlds(lds);
  int v0 = vblk() - 2 * 136; if (v0 < 0) v0 += vgrid();
  for (int u = v0; u < 128; u += vgrid()) {
    const int nt = u & 1, mt = (u >> 1) & 7, g = (u >> 4) & 3, l = u >> 6;
    BRowPlain br{c.WCS() + ((size_t)(l * 4 + g) * 128) * 256 + nt * 128, 256};
    EpiStoreBf16T ep{c.WIN() + ((size_t)l * NZ + ZP + nt * 512 + g * 128) * 1024 + mt * 128, 1024};
    gemm_tile<2, 2, 2, 2, false>(vl, c.WFA() + ((size_t)l * 1024 + mt * 128) * 512 + g * 128, 512, br, 128, ep);
  }
}

__device__ __forceinline__ void phase_g1(const Ctx& c, LAS char* lds, int l, int seg0, int nseg) {
  const size_t tok0 = (size_t)seg0 * CH_TOK; const int MG = nseg * CH_TOK;
  const bf16_t* A = c.XB() + tok0 * DM; const bf16_t* Bt = c.WIN() + (size_t)l * NZ * 1024;
  pg8::StaticOrder S; S.init(MG, NZ, (int)gridDim.x, (int)blockIdx.x);
  pg8::Gemm g{A, Bt, MG, NZ, DM}; pg8::EpiBf16Blk E{c.Z(), c.ZB(), (size_t)ZROWS};
  pg8::gemm_phase<pg8::EpiBf16Blk, pg8::StaticOrder, true, true>((PG8_LAS unsigned char*)lds, g, S, E);
  if (l == 0) {
    const int G = (int)gridDim.x, leftover = S.nwg % G; int cs = (int)blockIdx.x - leftover; if (cs < 0) cs += G;
    const int rt0 = seg0 == 0 ? 0 : 16, nrt = seg0 == 0 ? 16 : 18;
    pg8::Gemm g2{c.MEMN() + (size_t)rt0 * 256 * DM, c.WMKV() + (size_t)1024 * 1024, nrt * 256, 1024, DM}; pg8::StaticOrder S2; S2.init(nrt * 256, 1024, G, cs);
    pg8::EpiBf16 E2{c.MKV() + (size_t)rt0 * 256 * 2048 + 1024, 2048};
    pg8::gemm_phase<pg8::EpiBf16, pg8::StaticOrder, true, true>((PG8_LAS unsigned char*)lds, g2, S2, E2);
  }
}

__device__ __forceinline__ void phase_norm_fft1(const Ctx& c, LAS char* lds, int l, int ch, int si) {
  bf16_t* const TBs = c.TB() + (size_t)si * CH_TOK * 1024;
  const int S = ch == 0 ? 8192 : 2048, N1 = ch == 0 ? 64 : 32, N2 = ch == 0 ? 128 : 64, n1log = ch == 0 ? 6 : 5, MT = ch == 0 ? 2 : 1;
  const bf16_t* A1 = ch == 0 ? c.A1_128() : c.A1_64(); const float* tw = ch == 0 ? c.TW8192() : c.TW2048();
  LAS char* vl = vlds(lds);
  for (int u = vblk(); u < 2048; u += 2 * vgrid()) {
    const int u2 = u + vgrid(); const bool two = u2 < 2048;
    int v = u; const int nt = v & 3; v >>= 2; const int mt = v % MT; v /= MT; const int s2 = v % N2; const int b = v / N2;
    BRowFFT1 br{zp(c, si, (size_t)b * S + s2, ZP + nt * 128), (size_t)N2 * ZP_, (size_t)4 * ZROWS * 128, N1 - 1, n1log};
    EpiFFT1 ep{TBs + (size_t)b * N1 * 2 * N2 * 512 + nt * 128, tw, mt * 32, s2, N2};
    if (two) {
      int w = u2; const int nt2 = w & 3; w >>= 2; const int mt2 = w % MT; w /= MT; const int s22 = w % N2; const int b2 = w / N2;
      BRowFFT1 br2{zp(c, si, (size_t)b2 * S + s22, ZP + nt2 * 128), (size_t)N2 * ZP_, (size_t)4 * ZROWS * 128, N1 - 1, n1log};
      EpiFFT1 ep2{TBs + (size_t)b2 * N1 * 2 * N2 * 512 + nt2 * 128, tw, mt2 * 32, s22, N2};
      gemm_tile_dual(vl, A1 + (size_t)mt * 64 * 2 * N1, A1 + (size_t)mt2 * 64 * 2 * N1, 2 * N1, br, br2, 2 * N1, ep, ep2);
    } else gemm_tile<1, 4, 2, 1, false>(vl, A1 + (size_t)mt * 64 * 2 * N1, 2 * N1, br, 2 * N1, ep);
  }
  const int tid = otid(), lane = tid & 63, wid = tid >> 6;
  const float* qg = c.q_g + l * 64; const float* kg = c.k_g + l * 64; const float* vg = c.v_g + l * 512;
  for (int task = vblk() * 4 + wid; task < CH_TOK / 4; task += vgrid() * 4) {
    const int t0 = task * 4;
    { const int tok = t0 + (lane >> 4); const int pos = tok & (S - 1);
      head_norm_rope(zp(c, si, tok, ZK + (lane & 15) * 8), kg, c.ROPE() + (size_t)pos * 64, lane, 1.0f); }
  }
}

__device__ __forceinline__ void phase_mix(const Ctx& c, LAS char* lds, int l, int ch, int si) {
  bf16_t* const TBs = c.TB() + (size_t)si * CH_TOK * 1024;
  const int S = ch == 0 ? 8192 : 2048, N1 = ch == 0 ? 64 : 32, N2 = ch == 0 ? 128 : 64, MT = ch == 0 ? 2 : 1, slog = ch == 0 ? 13 : 11;
  const bf16_t* A3 = ch == 0 ? c.A3_128() : c.A3_64();
  const size_t tok0 = (size_t)ch * CH_TOK;
  const int wid = otid() >> 6;
  const int nqb = S / 128;
  const int n_att = 1024, n_mem = 512, n_sgu = 512, n_fft = 1024;
  { const int nqb8 = S / 256;
    for (int u = blockIdx.x; u < 512; u += gridDim.x) {
      const int hq = u & 3; int v = u >> 2; const int qb = v % nqb8; v /= nqb8; const int kvh = v & 1, b = v >> 1; const int h = kvh * 4 + hq;
      const size_t rq = (size_t)b * S + (size_t)qb * 256;
      attn_body::attn_unit<8>((const attn_body::bf16*)(zp(c, si, rq, ZQ + h * 64)), (const attn_body::bf16*)(zp(c, si, (size_t)b * S, ZK + kvh * 64)),
                              (const attn_body::bf16*)(zp(c, si, (size_t)b * S, ZV + kvh * 64)), (const attn_body::bf16*)(zp(c, si, rq, ZAG + h * 64)),
                              (attn_body::bf16*)(c.O() + (tok0 + rq) * DMIX + h * 64), S / 64, (char*)lds, c.q_g + l * 64, c.ROPE() + (size_t)(qb * 256) * 64);
    } }
  { const int wid8 = __builtin_amdgcn_readfirstlane((int)(threadIdx.x >> 6));
    for (int u = blockIdx.x; u < 256; u += gridDim.x) {
      const int head = u & 3, qb = u >> 2;
      const size_t rq = (size_t)qb * 256 + wid8 * 32; const size_t tg = tok0 + (size_t)qb * 256;
      const int mb = tg < NPROMPT_TOK ? (int)(tg >> 13) : 2 + (int)((tg - NPROMPT_TOK) >> 11);
      const bf16_t* kp = c.MKV() + ((size_t)mb * 256) * 2048 + l * 1024 + head * 128;
      attn_unit<128, true, 8>(lds, zp(c, si, rq, ZMQ + head * 128), ZP_, kp, 2048, kp + 512, 2048, 256, 0.08838834764831845f * 1.4426950408889634f,
                              zp(c, si, rq, ZMG + head * 128), ZP_, c.O() + (tok0 + rq) * DMIX + 1536 + head * 128, DMIX);
    } }
  LAS char* vl = vlds(lds);
  for (int u = vblk() + n_att + n_mem; u < n_att + n_mem + n_sgu + n_fft; u += vgrid()) {
    if (u < n_att + n_mem + n_sgu) {
      const int v = u - n_att - n_mem; const int head = v & 3, ck = v >> 2; const size_t r0 = (size_t)ck * 128;
      BRowPlain br{zp(c, si, r0, ZSV + head * 128), ZP_};
      EpiSGU ep{c.O() + (tok0 + r0) * DMIX + 1024 + head * 128, zp(c, si, r0, ZSU + head * 128), zp(c, si, r0, ZSG + head * 128), c.b_s + (l * 4 + head) * 128};
      gemm_tile<2, 2, 2, 2, false>(vl, c.WSB() + (size_t)(l * 4 + head) * 16384, 128, br, 128, ep, BXSguNorm{c.v_g + (l * 4 + head) * 128});
    } else {
      int v = u - n_att - n_mem - n_sgu; const int nt = v & 3; v >>= 2; const int mt = v % MT; v /= MT; const int k1 = v % N1; const int b = v / N1;
      BRowPlain br{TBs + ((size_t)(b * N1 + k1) * 2 * N2) * 512 + nt * 128, 512};
      const size_t tl = ((size_t)b << slog) + k1;
      EpiFFT3 ep{c.O() + (tok0 + tl) * DMIX + 512 + nt * 128, zp(c, si, tl, ZFG + nt * 128), mt * 64, N1};
      const int u2 = u + vgrid();
      if (u2 < n_att + n_mem + n_sgu + n_fft) {
        int w = u2 - n_att - n_mem - n_sgu; const int nt2 = w & 3; w >>= 2; const int mt2 = w % MT; w /= MT; const int k12 = w % N1; const int b2 = w / N1;
        BRowPlain br2{TBs + ((size_t)(b2 * N1 + k12) * 2 * N2) * 512 + nt2 * 128, 512};
        const size_t tl2 = ((size_t)b2 << slog) + k12;
        EpiFFT3 ep2{c.O() + (tok0 + tl2) * DMIX + 512 + nt2 * 128, zp(c, si, tl2, ZFG + nt2 * 128), mt2 * 64, N1};
        gemm_tile_dual(vl, A3 + (size_t)mt * 64 * 2 * N2, A3 + (size_t)mt2 * 64 * 2 * N2, 2 * N2, br, br2, 2 * N2, ep, ep2);
        u += vgrid();
      } else gemm_tile<1, 4, 2, 1, false>(vl, A3 + (size_t)mt * 64 * 2 * N2, 2 * N2, br, 2 * N2, ep);
    }
  }
}

__device__ __forceinline__ void phase_g2(const Ctx& c, LAS char* lds, int l) {
  pg8::Gemm g{c.O(), c.WOUT() + (size_t)l * 1024 * 2048, NTOK, DM, DMIX}; pg8::StaticOrder S; S.init(NTOK, DM, (int)gridDim.x, (int)blockIdx.x);
  pg8::EpiBf16 E{(bf16_t*)c.Y(), DM};
  pg8::gemm_phase<pg8::EpiBf16, pg8::StaticOrder, true, true>((PG8_LAS unsigned char*)lds, g, S, E);
}

__device__ __forceinline__ void phase_d(const Ctx& c, int l) {
  const int tid = otid(), lane = tid & 63, wid = tid >> 6;
  const float* pg = c.post_g + l * DM;
  float* rs2a = (float*)(c.ws + OFF_RS2);
  const int nw = vgrid() * 4;
  for (int row0 = vblk() * 4 + wid; row0 < NTOK; row0 += 2 * nw) {
    int rows[2]; rows[0] = row0; rows[1] = row0 + nw < NTOK ? row0 + nw : row0;
    f32x4 v[2][4], xv[2][4];
#pragma unroll
    for (int k = 0; k < 2; ++k) { const int row = rows[k];
      const bf16_t* y = (const bf16_t*)c.Y() + (size_t)row * DM;
#pragma unroll
      for (int i = 0; i < 4; ++i) { const u32x2 yw = *(const u32x2*)(y + lane * 4 + i * 256); v[k][i] = (f32x4){bf2f(yw[0] & 0xffffu), bf2f(yw[0] >> 16), bf2f(yw[1] & 0xffffu), bf2f(yw[1] >> 16)}; }
      { const bf16_t* xb = c.XB() + (size_t)row * DM; const float sc = rs2a[row];
#pragma unroll
        for (int i = 0; i < 4; ++i) { const u32x2 xw = *(const u32x2*)(xb + lane * 4 + i * 256); xv[k][i] = (f32x4){bf2f(xw[0] & 0xffffu) * sc, bf2f(xw[0] >> 16) * sc, bf2f(xw[1] & 0xffffu) * sc, bf2f(xw[1] >> 16) * sc}; } } }
#pragma unroll
    for (int k = 0; k < 2; ++k) { const int row = rows[k];
      if (k == 1 && rows[1] == rows[0]) break;
      float ss = 0.f;
#pragma unroll
      for (int i = 0; i < 4; ++i) ss += v[k][i][0] * v[k][i][0] + v[k][i][1] * v[k][i][1] + v[k][i][2] * v[k][i][2] + v[k][i][3] * v[k][i][3];
      ss = wave_sum(ss); const float rs = rsqrtf(ss * (1.0f / 1024.0f) + EPS);
      float ss2 = 0.f;
#pragma unroll
      for (int i = 0; i < 4; ++i) { const f32x4 g = *(const f32x4*)(pg + lane * 4 + i * 256);
        v[k][i] = xv[k][i] + v[k][i] * rs * g; ss2 += v[k][i][0] * v[k][i][0] + v[k][i][1] * v[k][i][1] + v[k][i][2] * v[k][i][2] + v[k][i][3] * v[k][i][3];
        if (l == 1) *(f32x4*)(c.out + (size_t)row * DM + lane * 4 + i * 256) = v[k][i]; }
      if (l == 0) {
        ss2 = wave_sum(ss2); const float ms = ss2 * (1.0f / 1024.0f) + EPS; const float rs2 = rsqrtf(ms);
        if (lane == 0) rs2a[row] = ms * rs2;
#pragma unroll
        for (int i = 0; i < 4; ++i) {
          u32x2 w; w[0] = pk2(v[k][i][0] * rs2, v[k][i][1] * rs2); w[1] = pk2(v[k][i][2] * rs2, v[k][i][3] * rs2);
          *(u32x2*)(c.XB() + (size_t)row * DM + lane * 4 + i * 256) = w; }
      }
    }
  }
}

__global__ void __launch_bounds__(512, 2) mega(Params p) {
  extern __shared__ __attribute__((aligned(16))) unsigned char lds_dyn[];
  LAS char* lds = (LAS char*)lds_dyn;
  Ctx c;
  c.x_prompt = p.in[0]; c.x_sample = p.in[1]; c.mem_prompt = p.in[2]; c.mem_sample = p.in[3]; c.pre_g = p.in[4]; c.w_in = p.in[5]; c.q_g = p.in[6]; c.k_g = p.in[7];
  c.w_f = p.in[8]; c.v_g = p.in[9]; c.w_s = p.in[10]; c.b_s = p.in[11]; c.mem_g = p.in[12]; c.w_mkv = p.in[13]; c.w_out = p.in[14]; c.post_g = p.in[15];
  c.out = p.out; c.ws = p.ws; char* ws = p.ws;
  cg::grid_group grid = cg::this_grid();
  volatile LAS unsigned* xbw = (volatile LAS unsigned*)(lds + LDS_XB);
  if (threadIdx.x < 4) xbw[threadIdx.x] = 0u;
  __syncthreads();
  const XcdBarrier xb = xcd_barrier_post((unsigned*)(ws + OFF_BAR), xbw);
  if (p.phase_hi > 1000) grid.sync();
  if (p.phase_lo == 0) {
    if (threadIdx.x < 128) { float sn, cs; sincospif((float)threadIdx.x / 64.0f, &sn, &cs); LAS float* ctab = (LAS float*)(lds + LDS_TAB); ctab[threadIdx.x] = cs; ctab[128 + threadIdx.x] = sn; }
    __syncthreads();
  }
  for (int ph = p.phase_lo; ph < p.phase_hi; ++ph) {
    if (ph == 0) phase_prep_a(c, lds);
    else if (ph == 1) phase_prep_b(c, lds);
    else {
      const int q = ph - 2, l = q / 8, r = q % 8;
      if (r < 6) { const int g = r / 3, st = r % 3, seg0 = 3 * g, nseg = g == 0 ? 3 : 2;
        if (st == 0) phase_g1(c, lds, l, seg0, nseg);
        else if (st == 1) { for (int si = 0; si < nseg; ++si) phase_norm_fft1(c, lds, l, seg0 + si, si); }
        else { for (int si = 0; si < nseg; ++si) phase_mix(c, lds, l, seg0 + si, si); }
      } else if (r == 6) phase_g2(c, lds, l);
      else phase_d(c, l);
    }
    if (ph + 1 < p.phase_hi) xcd_barrier(xb);
  }
}

extern "C" void kernel_launch(void* const* d_in, const int* in_sizes, int n_in, void* d_out, int out_size, void* d_ws, size_t ws_size, hipStream_t stream) {
  static int grid_blocks = 0;
  if (!grid_blocks) {
    int dev = 0, cus = 0, per_cu = 0;
    (void)hipGetDevice(&dev);
    (void)hipDeviceGetAttribute(&cus, hipDeviceAttributeMultiprocessorCount, dev);
    (void)hipFuncSetAttribute((const void*)mega, hipFuncAttributeMaxDynamicSharedMemorySize, LDS_BYTES);
    (void)hipOccupancyMaxActiveBlocksPerMultiprocessor(&per_cu, mega, 512, LDS_BYTES);
    (void)hipGetLastError();
    grid_blocks = cus;
  }
  if (ws_size < WS_NEED) { fprintf(stderr, "workspace too small: %zu < %zu\n", ws_size, (size_t)WS_NEED); return; }
  Params p{};
  for (int i = 0; i < 16; ++i) p.in[i] = (const float*)d_in[i];
  p.out = (float*)d_out; p.ws = (char*)d_ws; p.phase_lo = 0; p.phase_hi = NPHASE;
  (void)hipMemsetAsync((char*)d_ws + OFF_BAR, 0, XCD_BAR_WORDS * 4, stream);
  void* args[] = {&p};
  hipError_t e = hipLaunchCooperativeKernel((void*)mega, dim3(grid_blocks), dim3(512), args, LDS_BYTES, stream);
  if (e != hipSuccess) fprintf(stderr, "cooperative launch failed: %s (grid %d)\n", hipGetErrorString(e), grid_blocks);
}
```

```cpp
#include <hip/hip_runtime.h>
#include <hip/hip_cooperative_groups.h>
#include <hip/hip_bf16.h>
#include <cstdio>
#include <cstdint>
namespace cg = cooperative_groups;

typedef unsigned short bf16_t;
typedef short bf16x8 __attribute__((ext_vector_type(8)));
typedef short s16x4 __attribute__((ext_vector_type(4)));
typedef float f32x16 __attribute__((ext_vector_type(16)));
typedef float f32x4 __attribute__((ext_vector_type(4)));
typedef unsigned u32x4 __attribute__((ext_vector_type(4)));
typedef unsigned u32x2 __attribute__((ext_vector_type(2)));
#define LAS __attribute__((address_space(3)))

constexpr int DM = 1024, NTOK = 81920, NPROMPT_TOK = 16384, NZ = 5376, DMIX = 2048;
constexpr int CH_TOK = 16384, NCHUNK = 5, NMEMROWS = 8704;
constexpr int ZQ = 0, ZK = 512, ZV = 640, ZAG = 768, ZP = 1280, ZFG = 2304, ZSU = 2816, ZSV = 3328, ZSG = 3840, ZMQ = 4352, ZMG = 4864;
constexpr float EPS = 1e-6f;
constexpr int ZROWS = 49152, ZP_ = 128, ZBLKA = 21;
constexpr int NPHASE = 18;

constexpr size_t MiB = 1u << 20;
constexpr size_t OFF_XB = 0, OFF_O = 160 * MiB, OFF_ZY = 480 * MiB  , OFF_TB = 924 * MiB  , OFF_WIN = 832 * MiB, OFF_WFA = 854 * MiB,
                 OFF_WOUT = 856 * MiB, OFF_WMKV = 864 * MiB, OFF_MEMN = 868 * MiB, OFF_MKV = 885 * MiB, OFF_MISC = 919 * MiB;
constexpr size_t OFF_WCS = OFF_MISC, OFF_WSB = OFF_WCS + 524288, OFF_A1_64 = OFF_WSB + 262144, OFF_A1_128 = OFF_A1_64 + 8192,
                 OFF_A3_64 = OFF_A1_128 + 32768, OFF_A3_128 = OFF_A3_64 + 16384, OFF_TW8192 = OFF_A3_128 + 65536, OFF_TW2048 = OFF_TW8192 + 65536,
                 OFF_ROPE = OFF_TW2048 + 16384, OFF_BAR = 923 * MiB, OFF_RS2 = OFF_BAR + 512 * 1024  , WS_NEED = 1020 * MiB;
static_assert(OFF_ROPE + 2 * MiB <= OFF_BAR, "ws map");

struct Params { const float* in[16]; float* out; char* ws; int phase_lo, phase_hi; };

constexpr int LDS_HALF = 60416, LDS_TAB = 131072, LDS_XB = 132096, LDS_BYTES = 135168;

typedef float f32x2_t __attribute__((ext_vector_type(2))); typedef __bf16 bf16x2_t __attribute__((ext_vector_type(2)));
__device__ __forceinline__ unsigned pk2(float lo, float hi) { f32x2_t v = {lo, hi}; bf16x2_t b = __builtin_convertvector(v, bf16x2_t); return __builtin_bit_cast(unsigned, b); }
__device__ __forceinline__ unsigned f2bf(float f) { return pk2(f, 0.f) & 0xffffu; }
__device__ __forceinline__ float bf2f(unsigned h) { return __builtin_bit_cast(float, h << 16); }
__device__ __forceinline__ float silu(float x) { return x / (1.0f + __expf(-x)); }
__device__ __forceinline__ int crow(int r, int hi) { return (r & 3) + 8 * (r >> 2) + 4 * hi; }
__device__ __forceinline__ s16x4 tr16(LAS char* p) { return __builtin_bit_cast(s16x4, __builtin_amdgcn_ds_read_tr16_b64_v4i16((LAS s16x4*)p)); }
__device__ __forceinline__ int otid() { int t = threadIdx.x & 255; asm volatile("" : "+v"(t)); return t; }
__device__ __forceinline__ int vhalf() { return __builtin_amdgcn_readfirstlane((int)(threadIdx.x >> 8)); }
__device__ __forceinline__ int vblk() { return (int)blockIdx.x * 2 + vhalf(); }
__device__ __forceinline__ int vgrid() { return (int)gridDim.x * 2; }
__device__ __forceinline__ LAS char* vlds(LAS char* lds) { return lds + vhalf() * LDS_HALF; }
__device__ __forceinline__ float wave_sum(float v) {
#pragma unroll
  for (int o = 32; o >= 1; o >>= 1) v += __shfl_xor(v, o);
  return v;
}


#define XB_TMO      128
#define XB_XCNT(j)  (256  + 64 * (j))
#define XB_XSUB(j)  (1280 + 64 * (j))
#define XB_XGEN(j)  (2304 + 64 * (j))
#define XB_TOP      3328
#define XB_TOPGEN   3392
#define XCD_BAR_WORDS 3456
#define XB_SPIN_CAP (1u << 18)
__device__ __forceinline__ unsigned xb_ld(unsigned* p)              { return __hip_atomic_load(p, __ATOMIC_RELAXED, __HIP_MEMORY_SCOPE_AGENT); }
__device__ __forceinline__ unsigned xb_add(unsigned* p, unsigned v) { return __hip_atomic_fetch_add(p, v, __ATOMIC_RELAXED, __HIP_MEMORY_SCOPE_AGENT); }
__device__ __forceinline__ unsigned xb_xcc_id() { return (unsigned)__builtin_amdgcn_s_getreg((3 << 11) | 20) & 0xFu; }
#define XB_SPIN(cond, bar) do { unsigned _sp = 0; while (cond) { __builtin_amdgcn_s_sleep(1); \
    if ((++_sp & 255u) == 0u) { if (xb_ld(&(bar)[XB_TMO])) break; if (_sp > XB_SPIN_CAP) { atomicAdd(&(bar)[XB_TMO], 1u); break; } } } } while (0)
struct XcdBarrier { unsigned* bar; unsigned x; volatile LAS unsigned* st; };
__device__ __forceinline__ XcdBarrier xcd_barrier_post(unsigned* bar, volatile LAS unsigned* st) {
  XcdBarrier b; b.bar = bar; b.x = xb_xcc_id(); b.st = st;
  if (threadIdx.x == 0) (void)xb_add(&bar[XB_XCNT(b.x)], 1u);
  return b;
}
__device__ __forceinline__ void xcd_barrier_complete(unsigned* bar, unsigned x, unsigned& nloc, unsigned& nx) {
  const unsigned G = gridDim.x * gridDim.y * gridDim.z;
  unsigned sum, cnt, mine, sp = 0u;
  for (;;) {
    sum = 0u; cnt = 0u; mine = 0u;
#pragma unroll
    for (unsigned j = 0; j < 16; ++j) { const unsigned c = xb_ld(&bar[XB_XCNT(j)]); sum += c; cnt += (c > 0u) ? 1u : 0u; mine = (j == x) ? c : mine; }
    if (sum == G) break;
    __builtin_amdgcn_s_sleep(1);
    if ((++sp & 255u) == 0u) { if (xb_ld(&bar[XB_TMO])) break; if (sp > XB_SPIN_CAP) { atomicAdd(&bar[XB_TMO], 1u); break; } }
  }
  nloc = mine > 0u ? mine : 1u; nx = cnt > 0u ? cnt : 1u;
}
__device__ __forceinline__ void xcd_barrier(const XcdBarrier& b) {
  asm volatile("s_waitcnt vmcnt(0)" ::: "memory");
  __syncthreads();
  if (threadIdx.x == 0) {
    unsigned* bar = b.bar;
    __builtin_amdgcn_s_waitcnt(0);
    unsigned nloc = b.st[0], nx = b.st[1];
    if (nloc == 0u) { xcd_barrier_complete(bar, b.x, nloc, nx); b.st[0] = nloc; b.st[1] = nx; }
    const unsigned old = xb_add(&bar[XB_XSUB(b.x)], 1u);
    const unsigned gen = old / nloc;
    if (old + 1u == (gen + 1u) * nloc) {
      __builtin_amdgcn_fence(__ATOMIC_RELEASE, "agent");
      asm volatile("s_waitcnt vmcnt(0)" ::: "memory");
      const unsigned og = xb_add(&bar[XB_TOP], 1u);
      const unsigned tg = og / nx;
      if (og + 1u == (tg + 1u) * nx) xb_add(&bar[XB_TOPGEN], 1u);
      else XB_SPIN(xb_ld(&bar[XB_TOPGEN]) == tg, bar);
      __builtin_amdgcn_fence(__ATOMIC_ACQUIRE, "agent");
      xb_add(&bar[XB_XGEN(b.x)], 1u);
      asm volatile("s_waitcnt vmcnt(0)" ::: "memory");
    } else {
      XB_SPIN(xb_ld(&bar[XB_XGEN(b.x)]) == gen, bar);
      __builtin_amdgcn_fence(__ATOMIC_ACQUIRE, "agent");
      asm volatile("s_waitcnt vmcnt(0)" ::: "memory");
    }
  }
  __syncthreads();
}

namespace pg8 {
#define PG8_LAS __attribute__((address_space(3)))
typedef unsigned short bf16_t;
typedef short bf16x8 __attribute__((ext_vector_type(8)));
typedef float f32x4 __attribute__((ext_vector_type(4)));
typedef unsigned u32x4 __attribute__((ext_vector_type(4)));
constexpr int BM = 256, BK = 64, HALF = 128, HTB = HALF * BK * 2  , STAGE_BYTES = 8 * HTB, NXCD = 8, WGM = 4;

__host__ __device__ __forceinline__ int lds_byte(int r, int c) { const int st = (r >> 4) * 2 + (c >> 5), rr = r & 15, cc = c & 31, ob = rr * 64 + cc * 2; return st * 1024 + (ob ^ (((ob >> 9) & 1) << 5)); }
__host__ __device__ __forceinline__ void stage_rc(int b, int& R, int& C) { const int st = b / 1024, sb = b % 1024, swz = sb ^ (((sb >> 9) & 1) << 5); R = (st >> 1) * 16 + swz / 64; C = (st & 1) * 32 + (swz % 64) / 2; }
__host__ __device__ __forceinline__ int perm32(int rho) { const int n = rho >> 4, i = rho & 15; return 8 * (i >> 2) + 4 * n + (i & 3); }

struct Unit { int pm, pn; };
struct Gemm { const bf16_t* A; const bf16_t* Bt; int M, N, K; };

struct StaticOrder {
    int nM, nN, nwg, G, c;
    __host__ __device__ void init(int M, int N, int G_, int c_) { nM = M / BM; nN = N / BM; nwg = nM * nN; G = G_; c = c_; }
    __host__ __device__ bool next(int i, Unit& u) const {
        const long L = (long)i * G + c; if (L >= nwg) return false;
        int wgid = (int)L; { const int q = nwg / NXCD, r = nwg % NXCD, xcd = wgid % NXCD, off = wgid / NXCD; wgid = (xcd < r ? xcd * (q + 1) : r * (q + 1) + (xcd - r) * q) + off; }
        const int nig = WGM * nN, gid = wgid / nig, fm = gid * WGM, gsz = (nM - fm) < WGM ? (nM - fm) : WGM;
        u.pm = fm + ((wgid % nig) % gsz); u.pn = (wgid % nig) / gsz; return true;
    }
    __device__ __forceinline__ void a_ready(const Unit&) const {}
    __device__ __forceinline__ void done(const Unit&) const {}
};

__device__ __forceinline__ unsigned cvt_pk_bf16(float lo, float hi) { unsigned r; asm volatile("v_cvt_pk_bf16_f32 %0, %1, %2" : "=v"(r) : "v"(lo), "v"(hi)); return r; }
typedef float f32x2 __attribute__((ext_vector_type(2)));

struct EpiBf16 {
    static constexpr bool PERM = true, AFTER_DRAIN = false;
    bf16_t* O; int ldc;
    __device__ __forceinline__ void operator()(const f32x4 (&acc)[2][2][4][2], const Unit& u, int wr, int wc, int fr, int fq) const {
        const int row0 = u.pm * BM + wr * 64 + fr, col0 = u.pn * BM + wc * 32 + 8 * fq;
#pragma unroll
        for (int ai = 0; ai < 2; ++ai)
#pragma unroll
            for (int m = 0; m < 4; ++m) { bf16_t* rowp = O + (size_t)(row0 + ai * HALF + m * 16) * ldc + col0;
#pragma unroll
                for (int bj = 0; bj < 2; ++bj) { const f32x4 v0 = acc[ai][bj][m][0], v1 = acc[ai][bj][m][1];
                    u32x4 w; w.x = cvt_pk_bf16(v0[0], v0[1]); w.y = cvt_pk_bf16(v0[2], v0[3]); w.z = cvt_pk_bf16(v1[0], v1[1]); w.w = cvt_pk_bf16(v1[2], v1[3]);
                    *(u32x4*)(rowp + bj * HALF) = w; } }
    }
};
struct EpiBf16Blk {
    static constexpr bool PERM = true, AFTER_DRAIN = false;
    bf16_t* OA; bf16_t* OB; size_t zrows;
    __device__ __forceinline__ void operator()(const f32x4 (&acc)[2][2][4][2], const Unit& u, int wr, int wc, int fr, int fq) const {
        const int row0 = u.pm * BM + wr * 64 + fr, c0 = wc * 32 + 8 * fq;
#pragma unroll
        for (int bj = 0; bj < 2; ++bj) { const int bi = u.pn * 2 + bj; bf16_t* blk = (bi < 21 ? OA + (size_t)bi * zrows * 128 : OB + (size_t)(bi - 21) * zrows * 128) + c0;
#pragma unroll
            for (int ai = 0; ai < 2; ++ai)
#pragma unroll
                for (int m = 0; m < 4; ++m) { const f32x4 v0 = acc[ai][bj][m][0], v1 = acc[ai][bj][m][1];
                    u32x4 w; w.x = cvt_pk_bf16(v0[0], v0[1]); w.y = cvt_pk_bf16(v0[2], v0[3]); w.z = cvt_pk_bf16(v1[0], v1[1]); w.w = cvt_pk_bf16(v1[2], v1[3]);
                    *(u32x4*)(blk + (size_t)(row0 + ai * HALF + m * 16) * 128) = w; } }
    }
};
struct EpiF32 {
    static constexpr bool PERM = false, AFTER_DRAIN = false;
    float* O; int ldc;
    __device__ __forceinline__ void operator()(const f32x4 (&acc)[2][2][4][2], const Unit& u, int wr, int wc, int fr, int fq) const {
        const int row0 = u.pm * BM + wr * 64 + fr, col0 = u.pn * BM + wc * 32 + 4 * fq;
#pragma unroll
        for (int ai = 0; ai < 2; ++ai)
#pragma unroll
            for (int m = 0; m < 4; ++m) { float* rowp = O + (size_t)(row0 + ai * HALF + m * 16) * ldc + col0;
#pragma unroll
                for (int bj = 0; bj < 2; ++bj)
#pragma unroll
                    for (int n = 0; n < 2; ++n) *(f32x4*)(rowp + bj * HALF + n * 16) = acc[ai][bj][m][n]; }
    }
};
struct CutOrder : StaticOrder { int imax;
    __host__ __device__ bool next(int i, Unit& u) const { if (i >= imax) return false; return StaticOrder::next(i, u); } };
template <class Epi, class Sched, bool ALIGN_EPI = false, bool SP2 = false>
__device__ __forceinline__ void gemm_phase(PG8_LAS unsigned char* lds, const Gemm g, const Sched& S, const Epi& E) {
    int tid_ = threadIdx.x; asm volatile("" : "+v"(tid_));
    const int tid = tid_, wid = __builtin_amdgcn_readfirstlane(tid >> 6), lane = tid & 63, wr = wid >> 2, wc = wid & 3, fr = lane & 15, fq = lane >> 4;
    const int K = g.K, nt = K / BK;
    unsigned voffA[2], voffB[2];
#pragma unroll
    for (int i = 0; i < 2; ++i) { int R, C; stage_rc(tid * 16 + i * 8192, R, C); const int Rb = Epi::PERM ? ((R & ~31) + perm32(R & 31)) : R;
        voffA[i] = (unsigned)(R * K + C) * 2u; voffB[i] = (unsigned)(Rb * K + C) * 2u; }
    const size_t kstep = (size_t)(BK * 2);
    const size_t hstep = (size_t)HALF * K * 2;
    const size_t tstep = 2 * hstep;
    const unsigned ldsw = (unsigned)wid * 1024u;
    const int aoff = lds_byte(wr * 64 + fr, fq * 8), boff = lds_byte(wc * 32 + fr, fq * 8);
#define PG8_SA(b, h) (((b) * 2 + (h)) * HTB)
#define PG8_SB(b, h) ((4 + (b) * 2 + (h)) * HTB)
#define PG8_STAGE(bufoff, gbase, voff) do { _Pragma("unroll") for (int _i = 0; _i < 2; ++_i) \
        __builtin_amdgcn_global_load_lds((const unsigned*)((const char*)(gbase) + (voff)[_i]), (PG8_LAS unsigned*)(lds + (bufoff) + ldsw + _i * 8192), 16, 0, 0); } while (0)
#define PG8_LDA(dst, b, h) do { _Pragma("unroll") for (int m = 0; m < 4; ++m) _Pragma("unroll") for (int k = 0; k < 2; ++k) dst[m][k] = *(const PG8_LAS bf16x8*)(lds + PG8_SA(b, h) + aoff + m * 2048 + k * 1024); } while (0)
#define PG8_LDB(dst, b, h) do { _Pragma("unroll") for (int n = 0; n < 2; ++n) _Pragma("unroll") for (int k = 0; k < 2; ++k) dst[n][k] = *(const PG8_LAS bf16x8*)(lds + PG8_SB(b, h) + boff + n * 2048 + k * 1024); } while (0)
#define PG8_MMA(ai, bj, At, Bt) do { __builtin_amdgcn_s_setprio(1); _Pragma("unroll") for (int m = 0; m < 4; ++m) _Pragma("unroll") for (int n = 0; n < 2; ++n) _Pragma("unroll") for (int k = 0; k < 2; ++k) \
        acc[ai][bj][m][n] = __builtin_amdgcn_mfma_f32_16x16x32_bf16(Bt[n][k], At[m][k], acc[ai][bj][m][n], 0, 0, 0); __builtin_amdgcn_s_setprio(0); } while (0)
#define PG8_WAIT_V(n) asm volatile("s_waitcnt vmcnt(" #n ")" ::: "memory")
#define PG8_WAIT_L(n) asm volatile("s_waitcnt lgkmcnt(" #n ")" ::: "memory")
#define PG8_BAR __builtin_amdgcn_s_barrier()
#define PG8_SCHED __builtin_amdgcn_sched_barrier(0)
    Unit cur, nxt; int ui = 0;
    if (!S.next(0, cur)) return;
    f32x4 acc[2][2][4][2];
#pragma unroll
    for (int a = 0; a < 2; ++a)
#pragma unroll
        for (int b = 0; b < 2; ++b)
#pragma unroll
            for (int m = 0; m < 4; ++m)
#pragma unroll
                for (int n = 0; n < 2; ++n) acc[a][b][m][n] = (f32x4){0.f, 0.f, 0.f, 0.f};
    bf16x8 At[4][2], B0[2][2], B1[2][2];
    const char* cA = (const char*)g.A + (size_t)cur.pm * tstep; const char* cB = (const char*)g.Bt + (size_t)cur.pn * tstep;
    S.a_ready(cur);
    if constexpr (SP2) {
        PG8_STAGE(PG8_SB(0, 0), cB, voffB); PG8_STAGE(PG8_SB(0, 1), cB + hstep, voffB); PG8_STAGE(PG8_SA(0, 0), cA, voffA); PG8_STAGE(PG8_SA(0, 1), cA + hstep, voffA);
        if (wr == 1) PG8_BAR;
        PG8_WAIT_V(2); PG8_BAR;
        PG8_STAGE(PG8_SB(1, 0), cB + kstep, voffB); PG8_STAGE(PG8_SA(1, 0), cA + kstep, voffA); PG8_STAGE(PG8_SB(1, 1), cB + hstep + kstep, voffB);
        PG8_WAIT_V(6); PG8_BAR;
    } else {
        PG8_STAGE(PG8_SB(0, 0), cB, voffB); PG8_STAGE(PG8_SA(0, 0), cA, voffA); PG8_STAGE(PG8_SB(0, 1), cB + hstep, voffB); PG8_STAGE(PG8_SA(0, 1), cA + hstep, voffA);
        if (wr == 1) PG8_BAR;
        PG8_WAIT_V(4); PG8_BAR;
        PG8_STAGE(PG8_SB(1, 0), cB + kstep, voffB); PG8_STAGE(PG8_SA(1, 0), cA + kstep, voffA); PG8_STAGE(PG8_SB(1, 1), cB + hstep + kstep, voffB);
        PG8_WAIT_V(6); PG8_BAR;
    }
    for (;;) {
        const bool has_next = S.next(ui + 1, nxt);
        const char* nA = has_next ? (const char*)g.A + (size_t)nxt.pm * tstep : cA; const char* nB = has_next ? (const char*)g.Bt + (size_t)nxt.pn * tstep : cB;
        for (int t = 0; t < nt; t += 2) {
            const bool last = (t == nt - 2);
            const char* a1 = cA + (size_t)(t + 1) * kstep;
            const char* a2 = last ? nA : cA + (size_t)(t + 2) * kstep; const char* b2 = last ? nB : cB + (size_t)(t + 2) * kstep;
            const char* a3 = a2 + kstep; const char* b3 = b2 + kstep;
            if (last && has_next) S.a_ready(nxt);
            if constexpr (SP2) {
            PG8_LDB(B0, 0, 0); PG8_LDB(B1, 0, 1); PG8_SCHED; PG8_LDA(At, 0, 0); PG8_STAGE(PG8_SA(1, 1), a1 + hstep, voffA);
            PG8_WAIT_V(8); PG8_WAIT_L(0); PG8_BAR; PG8_MMA(0, 0, At, B0); PG8_MMA(0, 1, At, B1); PG8_BAR; PG8_SCHED;
            PG8_LDA(At, 0, 1); PG8_STAGE(PG8_SB(0, 0), b2, voffB); PG8_STAGE(PG8_SB(0, 1), b2 + hstep, voffB); PG8_STAGE(PG8_SA(0, 0), a2, voffA);
            PG8_WAIT_V(8); PG8_WAIT_L(0); PG8_BAR; PG8_MMA(1, 0, At, B0); PG8_MMA(1, 1, At, B1); PG8_BAR; PG8_SCHED;
            PG8_LDB(B0, 1, 0); PG8_LDB(B1, 1, 1); PG8_SCHED; PG8_LDA(At, 1, 0); PG8_STAGE(PG8_SA(0, 1), a2 + hstep, voffA);
            PG8_WAIT_V(8); PG8_WAIT_L(0); PG8_BAR; PG8_MMA(0, 0, At, B0); PG8_MMA(0, 1, At, B1); PG8_BAR; PG8_SCHED;
            PG8_LDA(At, 1, 1); PG8_STAGE(PG8_SB(1, 0), b3, voffB); PG8_STAGE(PG8_SB(1, 1), b3 + hstep, voffB); PG8_STAGE(PG8_SA(1, 0), a3, voffA);
            PG8_WAIT_V(8); PG8_WAIT_L(0); PG8_BAR; PG8_MMA(1, 0, At, B0); PG8_MMA(1, 1, At, B1); PG8_BAR; PG8_SCHED;
            } else {
            PG8_LDB(B0, 0, 0); PG8_SCHED; PG8_LDA(At, 0, 0); PG8_STAGE(PG8_SA(1, 1), a1 + hstep, voffA);
            PG8_WAIT_L(8); PG8_BAR; PG8_WAIT_L(0); PG8_MMA(0, 0, At, B0); PG8_BAR; PG8_SCHED;
            PG8_LDB(B1, 0, 1); PG8_STAGE(PG8_SB(0, 0), b2, voffB);
            PG8_BAR; PG8_WAIT_L(0); PG8_MMA(0, 1, At, B1); PG8_BAR;
            PG8_LDA(At, 0, 1); PG8_STAGE(PG8_SA(0, 0), a2, voffA);
            PG8_BAR; PG8_WAIT_L(0); PG8_MMA(1, 0, At, B0); PG8_BAR; PG8_SCHED;
            PG8_STAGE(PG8_SB(0, 1), b2 + hstep, voffB);
            PG8_WAIT_V(6); PG8_BAR; PG8_MMA(1, 1, At, B1); PG8_BAR;
            PG8_LDB(B0, 1, 0); PG8_SCHED; PG8_LDA(At, 1, 0); PG8_STAGE(PG8_SA(0, 1), a2 + hstep, voffA);
            PG8_WAIT_L(8); PG8_BAR; PG8_WAIT_L(0); PG8_MMA(0, 0, At, B0); PG8_BAR; PG8_SCHED;
            PG8_LDB(B1, 1, 1); PG8_STAGE(PG8_SB(1, 0), b3, voffB);
            PG8_BAR; PG8_WAIT_L(0); PG8_MMA(0, 1, At, B1); PG8_BAR;
            PG8_LDA(At, 1, 1); PG8_STAGE(PG8_SA(1, 0), a3, voffA);
            PG8_BAR; PG8_WAIT_L(0); PG8_MMA(1, 0, At, B0); PG8_BAR; PG8_SCHED;
            PG8_STAGE(PG8_SB(1, 1), b3 + hstep, voffB);
            PG8_WAIT_V(6); PG8_BAR; PG8_MMA(1, 1, At, B1); PG8_BAR;
            }
        }
        if constexpr (ALIGN_EPI) { if (wr == 0) PG8_BAR; }
        if constexpr (!Epi::AFTER_DRAIN) { E(acc, cur, wr, wc, fr, fq); S.done(cur); }
        if (!has_next) break;
#pragma unroll
        for (int a = 0; a < 2; ++a)
#pragma unroll
            for (int b = 0; b < 2; ++b)
#pragma unroll
                for (int m = 0; m < 4; ++m)
#pragma unroll
                    for (int n = 0; n < 2; ++n) acc[a][b][m][n] = (f32x4){0.f, 0.f, 0.f, 0.f};
        cur = nxt; cA = nA; cB = nB; ++ui;
        if constexpr (ALIGN_EPI) { if (wr == 1) PG8_BAR; }
    }
    PG8_WAIT_V(0);
    if constexpr (!ALIGN_EPI) { if (wr == 0) PG8_BAR; }
    PG8_BAR;
    if constexpr (Epi::AFTER_DRAIN) { E.fused(acc, cur, wr, wc, fr, fq, lds, wid, lane); S.done(cur); }
#undef PG8_SA
#undef PG8_SB
#undef PG8_STAGE
#undef PG8_LDA
#undef PG8_LDB
#undef PG8_MMA
#undef PG8_WAIT_V
#undef PG8_WAIT_L
#undef PG8_BAR
#undef PG8_SCHED
}
}

namespace attn_body {
using bf16=__hip_bfloat16;
using bf16x8=__attribute__((ext_vector_type(8)))short;
using s16x4=__attribute__((ext_vector_type(4)))short;
using f32x16=__attribute__((ext_vector_type(16)))float;
using u32x4=__attribute__((ext_vector_type(4)))unsigned;
constexpr int D=64,QP=128,OP=2048;
constexpr int NW=8,QBLK=32,QB=QBLK*NW,KVBLK=64;
__device__ __forceinline__ int crow(int r,int hi){return (r&3)+8*(r>>2)+4*hi;}
#define SBAR() __builtin_amdgcn_sched_barrier(0)
__device__ __forceinline__ void cmask(f32x16&p0,f32x16&p1,int jb,int qrel,int hi){
  const float NEG=-INFINITY; int kb=64*jb+4*hi;
  #pragma unroll
  for(int r=0;r<16;++r){int kv=kb+(r&3)+8*(r>>2); if(kv>qrel)p0[r]=NEG; if(kv+32>qrel)p1[r]=NEG;}
}

constexpr int NSLOT=3, SLOTB=8192;
constexpr int LDS_K=0, LDS_V=NSLOT*SLOTB, LDS_WS=2*NSLOT*SLOTB, LDS_OST=LDS_WS+NW*64*4, LDS_BYTES=LDS_OST+NW*4096;
constexpr float C2=0.125f*1.4426950408889634f;
__device__ __forceinline__ void glds16(const void*gsrc,unsigned lds_dst){unsigned keep;
  asm volatile("s_mov_b32 %0, m0\n\ts_mov_b32 m0, %2\n\ts_nop 0\n\tglobal_load_lds_dwordx4 %1, off\n\ts_mov_b32 m0, %0":"=&s"(keep):"v"(gsrc),"s"(lds_dst):"memory");}
__device__ __forceinline__ float max3f(float a,float b,float c){float r;asm("v_max3_f32 %0, %1, %2, %3":"=v"(r):"v"(a),"v"(b),"v"(c));return r;}
__device__ __forceinline__ float max2f(float a,float b){float r;asm("v_max_f32_e32 %0, %1, %2":"=v"(r):"v"(a),"v"(b));return r;}
__device__ __forceinline__ float fadd_s(float a,float b){float r;asm("v_add_f32_e32 %0, %1, %2":"=v"(r):"v"(a),"v"(b));return r;}
__device__ __forceinline__ float fsub_s(float a,float b){float r;asm("v_sub_f32_e32 %0, %1, %2":"=v"(r):"v"(a),"v"(b));return r;}
typedef float f32x2_t __attribute__((ext_vector_type(2))); typedef __bf16 bf16x2_t __attribute__((ext_vector_type(2)));
__device__ __forceinline__ unsigned cvtpk_s(float lo,float hi){f32x2_t v={lo,hi};bf16x2_t b=__builtin_convertvector(v,bf16x2_t);return __builtin_bit_cast(unsigned,b);}
#define WAIT_BAR(N) asm volatile("s_waitcnt vmcnt(" #N ") lgkmcnt(0)\n\ts_barrier":::"memory")

__device__ __forceinline__ void qkt(f32x16&p0,f32x16&p1,const char*Kslot,const bf16x8*qr,const f32x16&negm,int r32,int hi){
  const char*kb=Kslot+hi*1024+r32*16;
  #pragma unroll
  for(int d0=0;d0<4;++d0){
    const bf16x8 b0=*reinterpret_cast<const bf16x8*>(kb+d0*2048);
    const bf16x8 b1=*reinterpret_cast<const bf16x8*>(kb+d0*2048+512);
    if(d0==0){p0=__builtin_amdgcn_mfma_f32_32x32x16_bf16(b0,qr[0],negm,0,0,0);p1=__builtin_amdgcn_mfma_f32_32x32x16_bf16(b1,qr[0],negm,0,0,0);}
    else{p0=__builtin_amdgcn_mfma_f32_32x32x16_bf16(b0,qr[d0],p0,0,0,0);p1=__builtin_amdgcn_mfma_f32_32x32x16_bf16(b1,qr[d0],p1,0,0,0);}}
}
typedef __attribute__((address_space(3))) const char* lds_cptr;
typedef short v4i16_t __attribute__((ext_vector_type(4)));
__device__ __forceinline__ void kload8(bf16x8*kf,lds_cptr kp){
  kf[0]=*(const __attribute__((address_space(3))) bf16x8*)(kp);      kf[1]=*(const __attribute__((address_space(3))) bf16x8*)(kp+512);
  kf[2]=*(const __attribute__((address_space(3))) bf16x8*)(kp+2048); kf[3]=*(const __attribute__((address_space(3))) bf16x8*)(kp+2560);
  kf[4]=*(const __attribute__((address_space(3))) bf16x8*)(kp+4096); kf[5]=*(const __attribute__((address_space(3))) bf16x8*)(kp+4608);
  kf[6]=*(const __attribute__((address_space(3))) bf16x8*)(kp+6144); kf[7]=*(const __attribute__((address_space(3))) bf16x8*)(kp+6656);
}
__device__ __forceinline__ void kload2(bf16x8*kf,lds_cptr kp,int j){ kf[2*j]=*(const __attribute__((address_space(3))) bf16x8*)(kp+j*2048); kf[2*j+1]=*(const __attribute__((address_space(3))) bf16x8*)(kp+j*2048+512); }
__device__ __forceinline__ s16x4 vtr(lds_cptr p){ return __builtin_bit_cast(s16x4,__builtin_amdgcn_ds_read_tr16_b64_v4i16((__attribute__((address_space(3))) v4i16_t*)p)); }
__device__ __forceinline__ float rowmax(const f32x16&p0,const f32x16&p1){
  float a=max3f(p0[0],p0[1],p1[0]),b=max3f(p0[2],p0[3],p1[1]);a=max3f(a,p1[2],p1[3]);
  #pragma unroll
  for(int r=4;r<16;r+=4){a=max3f(a,p0[r],p0[r+1]);b=max3f(b,p0[r+2],p0[r+3]);a=max3f(a,p1[r],p1[r+1]);b=max3f(b,p1[r+2],p1[r+3]);}
  const float m=max2f(a,b);
  auto rr=__builtin_amdgcn_permlane32_swap(__float_as_uint(m),__float_as_uint(m),false,false);
  return max2f(__uint_as_float(rr[0]),__uint_as_float(rr[1]));
}
__device__ __forceinline__ void pv(f32x16*o,int vb,bf16x8 pa0,bf16x8 pa1,bf16x8 pa2,bf16x8 pa3){
  #pragma unroll
  for(int d0=0;d0<2;++d0){s16x4 lo[4],hi[4];
    #pragma unroll
    for(int ks=0;ks<4;++ks){
      asm volatile("ds_read_b64_tr_b16 %0,%1 offset:%c2":"=&v"(lo[ks]):"v"(vb),"i"(d0*4096+ks*1024):"memory");
      asm volatile("ds_read_b64_tr_b16 %0,%1 offset:%c2":"=&v"(hi[ks]):"v"(vb),"i"(d0*4096+ks*1024+512):"memory");}
    asm volatile("s_waitcnt lgkmcnt(0)":::"memory");SBAR();
    #define PK(k) (bf16x8){lo[k][0],lo[k][1],lo[k][2],lo[k][3],hi[k][0],hi[k][1],hi[k][2],hi[k][3]}
    o[d0]=__builtin_amdgcn_mfma_f32_32x32x16_bf16(pa0,PK(0),o[d0],0,0,0);
    o[d0]=__builtin_amdgcn_mfma_f32_32x32x16_bf16(pa1,PK(1),o[d0],0,0,0);
    o[d0]=__builtin_amdgcn_mfma_f32_32x32x16_bf16(pa2,PK(2),o[d0],0,0,0);
    o[d0]=__builtin_amdgcn_mfma_f32_32x32x16_bf16(pa3,PK(3),o[d0],0,0,0);
    #undef PK
  }
}

#ifndef ATTN_STORE16
#define ATTN_STORE16(p,v) (*(u32x4*)(p)=(v))
#endif
template<int THRL> __device__ __forceinline__ void attn_unit(const bf16*Qw0,const bf16*__restrict__ Kh,const bf16*__restrict__ Vh,const bf16*Gw0,bf16*Ow0,const int NT,char*shm,const float*qgain,const float*rope0){
  int tid_=threadIdx.x; asm volatile("":"+v"(tid_)); const int tid=tid_,lane=tid&63,r32=lane&31,hi=lane>>5; const int wid=__builtin_amdgcn_readfirstlane(tid>>6);
  const bf16*Qw=Qw0+(long)wid*QBLK*QP;
  const unsigned lds0=(unsigned)(uintptr_t)shm;
  float*wsf=(float*)(shm+LDS_WS)+wid*64;
  const bf16*ksrc=Kh+(long)lane*QP+wid*8;
  const bf16*vsrc=Vh+(long)(16*(wid&3)+(lane>>2))*QP+(wid>>2)*32+(lane&3)*8;
  const unsigned kdst=lds0+LDS_K+wid*1024, vdst=lds0+LDS_V+wid*1024;
  #define DMA_K(t,slot) glds16(ksrc+(long)(t)*KVBLK*QP,(unsigned)__builtin_amdgcn_readfirstlane(kdst+(slot)))
  #define DMA_V(t,slot) glds16(vsrc+(long)(t)*KVBLK*QP,(unsigned)__builtin_amdgcn_readfirstlane(vdst+(slot)))
  const int vb0=(int)(lds0+LDS_V)+((lane>>4)&1)*32+(lane&3)*8+(4*hi+((lane&15)>>2))*64;
  const char*Kbase=shm+LDS_K; bf16x8 kf[8];
  const lds_cptr shm3=(lds_cptr)shm; const lds_cptr kp0=shm3+LDS_K+hi*1024+r32*16; const lds_cptr vp0=shm3+LDS_V+((lane>>4)&1)*32+(lane&3)*8+(4*hi+((lane&15)>>2))*64;
  DMA_K(0,0);DMA_V(0,0);DMA_K(1,SLOTB);
  bf16x8 qr[4];
  #pragma unroll
  for(int d0=0;d0<4;++d0)qr[d0]=*reinterpret_cast<const bf16x8*>(&Qw[(long)r32*QP+d0*16+hi*8]);
  { float qf[4][8]; float ss=0.f;
    #pragma unroll
    for(int d0=0;d0<4;++d0){
      #pragma unroll
      for(int j=0;j<8;++j){ qf[d0][j]=__uint_as_float(((unsigned)(unsigned short)qr[d0][j])<<16); ss+=qf[d0][j]*qf[d0][j]; } }
    ss+=__shfl_xor(ss,32); const float rs=rsqrtf(ss*(1.0f/64.0f)+1e-6f);
    const float*rp=rope0+(long)(wid*QBLK+r32)*64;
    #pragma unroll
    for(int d0=0;d0<4;++d0){
      #pragma unroll
      for(int j=0;j<8;++j) qf[d0][j]*=rs*qgain[16*d0+8*hi+j]; }
    #pragma unroll
    for(int a=0;a<2;++a){
      #pragma unroll
      for(int j=0;j<8;++j){ const float co=rp[a*16+8*hi+j],si=rp[32+a*16+8*hi+j]; const float x1=qf[2*a][j],x2=qf[2*a+1][j]; qf[2*a][j]=(x1*co-x2*si)*C2; qf[2*a+1][j]=(x2*co+x1*si)*C2; } }
    #pragma unroll
    for(int d0=0;d0<4;++d0){ u32x4 w; w[0]=cvtpk_s(qf[d0][0],qf[d0][1]); w[1]=cvtpk_s(qf[d0][2],qf[d0][3]); w[2]=cvtpk_s(qf[d0][4],qf[d0][5]); w[3]=cvtpk_s(qf[d0][6],qf[d0][7]); qr[d0]=__builtin_bit_cast(bf16x8,w); } }
  float mhat=0.f,l_reg=0.f;f32x16 o[2];o[0]=f32x16{};o[1]=f32x16{};f32x16 negm=f32x16{};asm volatile("":"+v"(negm));
  #define CMASK(P0,P1,t) do{}while(0)
  bool resc=false;
  #define START(P0,P1) do{ const float rm=rowmax(P0,P1); resc=false; \
    { const float dl=rm; mhat=fadd_s(mhat,dl); \
      _Pragma("unroll") for(int r=0;r<16;++r){P0[r]=fsub_s(P0[r],dl);P1[r]=fsub_s(P1[r],dl);} \
      _Pragma("unroll") for(int r=0;r<16;++r)negm[r]=-mhat; asm volatile("":"+v"(negm)); } \
    _Pragma("unroll") for(int r=0;r<16;++r)P0[r]=__builtin_amdgcn_exp2f(P0[r]); }while(0)
  #define RESC() do{ if(resc){ asm volatile("s_waitcnt lgkmcnt(0)":::"memory"); \
      _Pragma("unroll") for(int d_=0;d_<2;++d_) _Pragma("unroll") for(int r=0;r<16;++r)o[d_][r]*=wsf[crow(r,hi)]; } }while(0)
  f32x16 pA0,pA1,pB0,pB1;
  int sl_prev=0,sl_cur=0,sl_next=SLOTB;
  #define ROT() do{sl_prev=sl_cur;sl_cur=sl_next;sl_next=(sl_next==(NSLOT-1)*SLOTB)?0:sl_next+SLOTB;}while(0)
  DMA_K(2,2*SLOTB);
  WAIT_BAR(3);
  qkt(pA0,pA1,Kbase,qr,negm,r32,hi);asm volatile("s_nop 15\n\ts_nop 7":"+v"(pA0),"+v"(pA1));CMASK(pA0,pA1,0);
  START(pA0,pA1);
  _Pragma("unroll") for(int r=0;r<16;++r)pA1[r]=__builtin_amdgcn_exp2f(pA1[r]);
  WAIT_BAR(0);
  DMA_K(3,0);DMA_V(1,SLOTB);
  ROT();
  kload8(kf,kp0+sl_cur);
  WAIT_BAR(2);
  s16x4 vlo[8],vhi[8]; u32x4 pw0,pw1,pw2,pw3;
  #define PKW(P,B) cvtpk_s(P[B],P[B+1])
  #define PAF(k) __builtin_bit_cast(bf16x8,pw##k)
  #define VFR(i) (bf16x8){vlo[i][0],vlo[i][1],vlo[i][2],vlo[i][3],vhi[i][0],vhi[i][1],vhi[i][2],vhi[i][3]}
  #define PIN(x) asm volatile("":"+v"(x))
  #define MX3(a,b,c) __builtin_fmaxf(__builtin_fmaxf((a),(b)),(c))
  #define GAPA(MF,A0,A1,A2,A3,W0,W1,PW) do{ MF; sacc+=A0; sacc+=A1; sacc+=A2; sacc+=A3; PIN(sacc); W0; W1; PIN(PW); SBAR(); }while(0)
  #define EX(v) __builtin_amdgcn_exp2f(v)
  #define GAPB(MF,X,B) do{ MF; X[B]=EX(X[B]); X[B+1]=EX(X[B+1]); X[B+2]=EX(X[B+2]); X[B+3]=EX(X[B+3]); PIN(X); SBAR(); }while(0)
  #define VRD(i) do{ vlo[i]=vtr(vp_+(((i)>>2)*4096+((i)&3)*1024)); vhi[i]=vtr(vp_+(((i)>>2)*4096+((i)&3)*1024+512)); }while(0)
  #define KRD(G,j) do{ if(G){ kload2(kf,kp0+sl_next,j); SBAR(); } }while(0)
  #define STEP(C0,C1,P0,P1,t,GK,GV,GL) do{ SBAR(); \
    const lds_cptr vp_=vp0+sl_prev; \
    VRD(0); SBAR(); float sacc=(P0[0]+P0[1]); \
    GAPA(C0=__builtin_amdgcn_mfma_f32_32x32x16_bf16(kf[0],qr[0],negm,0,0,0), P0[2],P0[3],P0[4],P0[5],     pw0[0]=PKW(P0,0), pw0[1]=PKW(P0,2), pw0); \
    VRD(4); SBAR(); GAPA(C1=__builtin_amdgcn_mfma_f32_32x32x16_bf16(kf[1],qr[0],negm,0,0,0), P0[6],P0[7],P0[8],P0[9],     pw0[2]=PKW(P0,4), pw0[3]=PKW(P0,6), pw0); \
    VRD(1); SBAR(); GAPA(C0=__builtin_amdgcn_mfma_f32_32x32x16_bf16(kf[2],qr[1],C0,0,0,0),   P0[10],P0[11],P0[12],P0[13], pw1[0]=PKW(P0,8), pw1[1]=PKW(P0,10), pw1); \
    VRD(5); SBAR(); GAPA(C1=__builtin_amdgcn_mfma_f32_32x32x16_bf16(kf[3],qr[1],C1,0,0,0),   P0[14],P0[15],P1[0],P1[1],   pw1[2]=PKW(P0,12),pw1[3]=PKW(P0,14), pw1); \
    VRD(2); SBAR(); GAPA(C0=__builtin_amdgcn_mfma_f32_32x32x16_bf16(kf[4],qr[2],C0,0,0,0),   P1[2],P1[3],P1[4],P1[5],     pw2[0]=PKW(P1,0), pw2[1]=PKW(P1,2), pw2); \
    VRD(6); SBAR(); GAPA(C1=__builtin_amdgcn_mfma_f32_32x32x16_bf16(kf[5],qr[2],C1,0,0,0),   P1[6],P1[7],P1[8],P1[9],     pw2[2]=PKW(P1,4), pw2[3]=PKW(P1,6), pw2); \
    VRD(3); SBAR(); GAPA(C0=__builtin_amdgcn_mfma_f32_32x32x16_bf16(kf[6],qr[3],C0,0,0,0),   P1[10],P1[11],P1[12],P1[13], pw3[0]=PKW(P1,8), pw3[1]=PKW(P1,10), pw3); \
    VRD(7); SBAR(); GAPA(C1=__builtin_amdgcn_mfma_f32_32x32x16_bf16(kf[7],qr[3],C1,0,0,0),   P1[14],P1[15],0.f,0.f,       pw3[2]=PKW(P1,12),pw3[3]=PKW(P1,14), pw3); \
    l_reg+=sacc; \
    if(GK){DMA_K((t)+3,sl_cur);} if(GV){DMA_V((t)+1,sl_next);} \
    CMASK(C0,C1,t); \
    { float a=MX3(C0[0],C0[1],C1[0]),b=MX3(C0[2],C0[3],C1[1]); a=MX3(a,C1[2],C1[3]); \
      _Pragma("unroll") for(int r=4;r<16;r+=4){a=MX3(a,C0[r],C0[r+1]);b=MX3(b,C0[r+2],C0[r+3]);a=MX3(a,C1[r],C1[r+1]);b=MX3(b,C1[r+2],C1[r+3]);} \
      float rm=__builtin_fmaxf(a,b); { auto rr=__builtin_amdgcn_permlane32_swap(__float_as_uint(rm),__float_as_uint(rm),false,false); rm=__builtin_fmaxf(__uint_as_float(rr[0]),__uint_as_float(rr[1])); } \
      resc=false; \
      if(__builtin_expect(__any(rm>(float)THRL),0)){ const float dl=__builtin_fmaxf(rm,0.f); mhat+=dl; \
        _Pragma("unroll") for(int r=0;r<16;++r){C0[r]-=dl;C1[r]-=dl;} \
        _Pragma("unroll") for(int r=0;r<16;++r)negm[r]=-mhat; asm volatile("":"+v"(negm)); \
        const float f=__builtin_amdgcn_exp2f(-dl); l_reg*=f; if(hi==0)wsf[r32]=f; resc=true; } } \
    SBAR(); \
    GAPB(o[0]=__builtin_amdgcn_mfma_f32_32x32x16_bf16(PAF(0),VFR(0),o[0],0,0,0), C0,0); \
    GAPB(o[1]=__builtin_amdgcn_mfma_f32_32x32x16_bf16(PAF(0),VFR(4),o[1],0,0,0), C0,4); \
    KRD(GL,0); GAPB(o[0]=__builtin_amdgcn_mfma_f32_32x32x16_bf16(PAF(1),VFR(1),o[0],0,0,0), C0,8); \
    KRD(GL,1); GAPB(o[1]=__builtin_amdgcn_mfma_f32_32x32x16_bf16(PAF(1),VFR(5),o[1],0,0,0), C0,12); \
    KRD(GL,2); GAPB(o[0]=__builtin_amdgcn_mfma_f32_32x32x16_bf16(PAF(2),VFR(2),o[0],0,0,0), C1,0); \
    KRD(GL,3); GAPB(o[1]=__builtin_amdgcn_mfma_f32_32x32x16_bf16(PAF(2),VFR(6),o[1],0,0,0), C1,4); \
    GAPB(o[0]=__builtin_amdgcn_mfma_f32_32x32x16_bf16(PAF(3),VFR(3),o[0],0,0,0), C1,8); \
    GAPB(o[1]=__builtin_amdgcn_mfma_f32_32x32x16_bf16(PAF(3),VFR(7),o[1],0,0,0), C1,12); \
    }while(0)
  int t=1;
  for(;t+5<NT;t+=2){
    STEP(pB0,pB1,pA0,pA1,t,true,true,true);     WAIT_BAR(2); RESC(); ROT();
    STEP(pA0,pA1,pB0,pB1,t+1,true,true,true);   WAIT_BAR(2); RESC(); ROT();
  }
  #define ENDW(tt) do{ if((tt)+3<NT){WAIT_BAR(2);} else if((tt)+2<NT){WAIT_BAR(1);} else {WAIT_BAR(0);} }while(0)
  for(;t+1<NT;t+=2){
    STEP(pB0,pB1,pA0,pA1,t,(t+3<NT),(t+1<NT),(t+1<NT));       ENDW(t);   RESC(); ROT();
    STEP(pA0,pA1,pB0,pB1,t+1,(t+4<NT),(t+2<NT),(t+2<NT));     ENDW(t+1); RESC(); ROT();
  }
  STEP(pB0,pB1,pA0,pA1,NT-1,false,false,false); RESC();
  { float sacc=pB0[0]+pB0[1]; _Pragma("unroll") for(int r=2;r<16;++r)sacc+=pB0[r]; _Pragma("unroll") for(int r=0;r<16;++r)sacc+=pB1[r]; l_reg+=sacc;
    pw0=(u32x4){PKW(pB0,0),PKW(pB0,2),PKW(pB0,4),PKW(pB0,6)};pw1=(u32x4){PKW(pB0,8),PKW(pB0,10),PKW(pB0,12),PKW(pB0,14)};pw2=(u32x4){PKW(pB1,0),PKW(pB1,2),PKW(pB1,4),PKW(pB1,6)};pw3=(u32x4){PKW(pB1,8),PKW(pB1,10),PKW(pB1,12),PKW(pB1,14)};
    SBAR(); pv(o,vb0+sl_cur,PAF(0),PAF(1),PAF(2),PAF(3)); }
  #undef PKW
  #undef PAF
  #undef VFR
  #undef PIN
  #undef MX3
  #undef GAPA
  #undef GAPB
  #undef EX
  #undef VRD
  #undef KRD
  #undef STEP
  #undef ENDW
  {auto rr=__builtin_amdgcn_permlane32_swap(__float_as_uint(l_reg),__float_as_uint(l_reg),false,false);l_reg=__uint_as_float(rr[0])+__uint_as_float(rr[1]);}
  if(hi==0)wsf[32+r32]=l_reg;asm volatile("s_waitcnt lgkmcnt(0)":::"memory");
  float rli[16];
  #pragma unroll
  for(int r=0;r<16;++r)rli[r]=__builtin_amdgcn_rcpf(wsf[32+crow(r,hi)]);
  bf16*Ow=Ow0+(long)wid*QBLK*OP; const bf16*Gw=Gw0+(long)wid*QBLK*QP;
  u32x4 gq[4];
  #pragma unroll
  for(int i=0;i<4;++i)gq[i]=*(const u32x4*)(Gw+(long)(i*8+(lane>>3))*QP+(lane&7)*8);
  { bf16*stg=(bf16*)(shm+LDS_OST)+wid*2048;
    #pragma unroll
    for(int r=0;r<16;++r){const int orow=crow(r,hi);
      #pragma unroll
      for(int d0=0;d0<2;++d0)stg[orow*64+d0*32+r32]=__float2bfloat16(o[d0][r]*rli[r]);}
    asm volatile("s_waitcnt lgkmcnt(0)":::"memory");
    #pragma unroll
    for(int i=0;i<4;++i){const int row=i*8+(lane>>3),ch=lane&7; const u32x4 v=*(const u32x4*)(stg+row*64+ch*8); const u32x4 g=gq[i]; u32x4 w;
      #pragma unroll
      for(int e=0;e<4;++e){ const float g0=__uint_as_float(g[e]<<16),g1=__uint_as_float(g[e]&0xffff0000u); const float v0=__uint_as_float(v[e]<<16),v1=__uint_as_float(v[e]&0xffff0000u);
        w[e]=cvtpk_s(v0*g0/(1.0f+__expf(-g0)),v1*g1/(1.0f+__expf(-g1))); }
      ATTN_STORE16(Ow+(long)row*OP+ch*8,w);} }
  asm volatile("s_waitcnt lgkmcnt(0)\n\ts_barrier":::"memory");
  #undef DMA_K
  #undef DMA_V
  #undef CMASK
  #undef START
  #undef RESC
  #undef ROT
}
constexpr int ATTN_LDS_BYTES=LDS_BYTES;

#undef SBAR
#undef WAIT_BAR
}

struct BRowPlain { const bf16_t* B; size_t ldb; __device__ __forceinline__ const bf16_t* operator()(int k) const { return B + (size_t)k * ldb; } };
struct BRowFFT1 { const bf16_t* B; size_t rs, ps; int n1mask, n1log; __device__ __forceinline__ const bf16_t* operator()(int k) const { return B + (size_t)(k & n1mask) * rs + (size_t)(k >> n1log) * ps; } };

struct NoBX { __device__ __forceinline__ void apply(u32x4 (&rb)[4], int tid) const {} };
struct BXSguNorm { const float* vg;
  __device__ __forceinline__ void apply(u32x4 (&rb)[4], int tid) const {
    float g[8];
#pragma unroll
    for (int e = 0; e < 8; ++e) g[e] = vg[(tid & 15) * 8 + e];
#pragma unroll
    for (int i = 0; i < 4; ++i) { float v[8];
#pragma unroll
      for (int e = 0; e < 4; ++e) { v[2 * e] = bf2f(rb[i][e] & 0xffffu); v[2 * e + 1] = bf2f(rb[i][e] >> 16); }
      float ss = 0.f;
#pragma unroll
      for (int e = 0; e < 8; ++e) ss += v[e] * v[e];
      ss += __shfl_xor(ss, 1); ss += __shfl_xor(ss, 2); ss += __shfl_xor(ss, 4); ss += __shfl_xor(ss, 8);
      const float rs = rsqrtf(ss * (1.0f / 128.0f) + EPS);
#pragma unroll
      for (int e = 0; e < 4; ++e) rb[i][e] = pk2(v[2 * e] * rs * g[2 * e], v[2 * e + 1] * rs * g[2 * e + 1]); }
  } };
template <int WM, int WN, int MI, int NI, bool BT, class BRow, class Epi, class BX = NoBX>
__device__ __forceinline__ void gemm_tile(LAS char* lds, const bf16_t* __restrict__ A, int lda, const BRow& brow, int K, const Epi& epi, const BX bx = BX()) {
  constexpr int BM = WM * MI * 32, BN = WN * NI * 32;
  static_assert(BN == 128 && WM * WN == 4, "tile config");
  constexpr int AP = 144, BP = 320, BOFF = BM * AP, ACH = BM * 8 / 256;
  const int tid = otid(), lane = tid & 63, wid = __builtin_amdgcn_readfirstlane(tid >> 6), wm = wid / WN, wn = wid % WN, r32 = lane & 31, hi = lane >> 5;
  u32x4 ra[ACH], rb[4];
  f32x16 acc[MI][NI];
#pragma unroll
  for (int mi = 0; mi < MI; ++mi)
#pragma unroll
    for (int ni = 0; ni < NI; ++ni)
#pragma unroll
      for (int r = 0; r < 16; ++r) acc[mi][ni][r] = 0.f;
#define GT_GLOAD(k0) do { \
    _Pragma("unroll") for (int i = 0; i < ACH; ++i) { const int c = tid + 256 * i; ra[i] = *(const u32x4*)(A + (size_t)(c >> 3) * lda + (k0) + (c & 7) * 8); } \
    _Pragma("unroll") for (int i = 0; i < 4; ++i) { const int c = tid + 256 * i; rb[i] = BT ? *(const u32x4*)(brow(c >> 3) + (k0) + (c & 7) * 8) : *(const u32x4*)(brow((k0) + (c >> 4)) + (c & 15) * 8); } } while (0)
#define GT_SSTORE() do { bx.apply(rb, tid); \
    _Pragma("unroll") for (int i = 0; i < ACH; ++i) { const int c = tid + 256 * i; *(LAS u32x4*)(lds + (c >> 3) * AP + (c & 7) * 16) = ra[i]; } \
    _Pragma("unroll") for (int i = 0; i < 4; ++i) { const int c = tid + 256 * i; *(LAS u32x4*)(lds + BOFF + (BT ? (c >> 3) * AP + (c & 7) * 16 : (c >> 4) * BP + (c & 15) * 16)) = rb[i]; } } while (0)
  GT_GLOAD(0); GT_SSTORE(); __syncthreads();
  const int nk = K >> 6;
  LAS char* abase = lds + (wm * MI * 32 + r32) * AP + hi * 16;
  LAS char* bbase = lds + BOFF + (8 * hi + ((lane & 15) >> 2)) * BP + (wn * NI * 32 + ((lane >> 4) & 1) * 16 + (lane & 3) * 4) * 2;
  LAS char* btbase = lds + BOFF + (wn * NI * 32 + r32) * AP + hi * 16;
  for (int kt = 0; kt < nk; ++kt) {
    if (kt + 1 < nk) GT_GLOAD((kt + 1) * 64);
#pragma unroll
    for (int kk = 0; kk < 4; ++kk) {
      bf16x8 af[MI], bfv[NI];
#pragma unroll
      for (int mi = 0; mi < MI; ++mi) af[mi] = *(LAS bf16x8*)(abase + mi * 32 * AP + kk * 32);
#pragma unroll
      for (int ni = 0; ni < NI; ++ni) {
        if (BT) bfv[ni] = *(LAS bf16x8*)(btbase + ni * 32 * AP + kk * 32);
        else { const s16x4 lo = tr16(bbase + kk * 16 * BP + ni * 64), h4 = tr16(bbase + (kk * 16 + 4) * BP + ni * 64);
          bfv[ni] = (bf16x8){lo[0], lo[1], lo[2], lo[3], h4[0], h4[1], h4[2], h4[3]}; } }
#pragma unroll
      for (int mi = 0; mi < MI; ++mi)
#pragma unroll
        for (int ni = 0; ni < NI; ++ni) acc[mi][ni] = __builtin_amdgcn_mfma_f32_32x32x16_bf16(af[mi], bfv[ni], acc[mi][ni], 0, 0, 0);
    }
    __syncthreads();
    if (kt + 1 < nk) { GT_SSTORE(); __syncthreads(); }
  }
#undef GT_GLOAD
#undef GT_SSTORE
  if constexpr (Epi::STAGED) {
    const int rb = wm * MI * 32, cb = wn * NI * 32;
    constexpr int SP = NI * 64 + 16, CPR = NI * 4, RPP = 64 / CPR, NP = MI * 32 / RPP;
    typename Epi::Ops ops[NP];
#pragma unroll
    for (int ps = 0; ps < NP; ++ps) ops[ps] = epi.load(rb + ps * RPP + lane / CPR, cb + (lane % CPR) * 8);
    epi.pre(acc, rb, cb, r32, hi);
    LAS char* st = lds + wid * (MI * 32 * SP);
#pragma unroll
    for (int mi = 0; mi < MI; ++mi)
#pragma unroll
      for (int ni = 0; ni < NI; ++ni)
#pragma unroll
        for (int r = 0; r < 16; ++r) *(LAS bf16_t*)(st + (mi * 32 + crow(r, hi)) * SP + (ni * 32 + r32) * 2) = (bf16_t)f2bf(acc[mi][ni][r]);
    asm volatile("s_waitcnt lgkmcnt(0)" ::: "memory");
#pragma unroll
    for (int ps = 0; ps < NP; ++ps) { const int row = ps * RPP + lane / CPR, chk = lane % CPR;
      const u32x4 v = *(LAS u32x4*)(st + row * SP + chk * 16); epi.fin(rb + row, cb + chk * 8, v, ops[ps]); }
    __syncthreads();
  } else epi(acc, wm * MI * 32, wn * NI * 32, r32, hi);
}

__device__ __forceinline__ float silu_f(float x) { return x / (1.0f + __expf(-x)); }
__device__ __forceinline__ u32x4 mul_silu8(const u32x4 v, const u32x4 g) { u32x4 w;
#pragma unroll
  for (int e = 0; e < 4; ++e) { const float g0 = bf2f(g[e] & 0xffffu), g1 = bf2f(g[e] >> 16); w[e] = pk2(bf2f(v[e] & 0xffffu) * silu_f(g0), bf2f(v[e] >> 16) * silu_f(g1)); }
  return w; }
struct EpiStoreBf16 { bf16_t* C; size_t ldc; static constexpr bool STAGED = true;
  template <int MI, int NI> __device__ __forceinline__ void pre(f32x16 (&acc)[MI][NI], int rb, int cb, int r32, int hi) const {}
  struct Ops {};
  __device__ __forceinline__ Ops load(int row, int col) const { return Ops{}; }
  __device__ __forceinline__ void fin(int row, int col, const u32x4 v, const Ops&) const { *(u32x4*)(C + (size_t)row * ldc + col) = v; } };
struct EpiStoreBf16T { bf16_t* CT; size_t ldt; static constexpr bool STAGED = false;
  template <int MI, int NI> __device__ __forceinline__ void operator()(const f32x16 (&acc)[MI][NI], int rb, int cb, int r32, int hi) const {
#pragma unroll
    for (int mi = 0; mi < MI; ++mi)
#pragma unroll
      for (int ni = 0; ni < NI; ++ni)
#pragma unroll
        for (int g = 0; g < 4; ++g) { u32x2 w; w[0] = pk2(acc[mi][ni][4 * g], acc[mi][ni][4 * g + 1]); w[1] = pk2(acc[mi][ni][4 * g + 2], acc[mi][ni][4 * g + 3]);
          *(u32x2*)(CT + (size_t)(cb + ni * 32 + r32) * ldt + rb + mi * 32 + 8 * g + 4 * hi) = w; }
  } };
struct EpiFFT1 { bf16_t* TBb; const float* tw; int k1base, s2, N2; static constexpr bool STAGED = true;
  template <int MI, int NI> __device__ __forceinline__ void pre(f32x16 (&acc)[MI][NI], int rb, int cb, int r32, int hi) const {
    static_assert(MI == 2 && NI == 1, "fft1 cfg");
#pragma unroll
    for (int r = 0; r < 16; ++r) { const int k1 = k1base + crow(r, hi); const float co = tw[2 * (k1 * s2)], si = tw[2 * (k1 * s2) + 1];
      const float tr = acc[0][0][r], ti = acc[1][0][r];
      acc[0][0][r] = tr * co + ti * si; acc[1][0][r] = ti * co - tr * si; }
  }
  struct Ops {};
  __device__ __forceinline__ Ops load(int row, int col) const { return Ops{}; }
  __device__ __forceinline__ void fin(int row, int col, const u32x4 v, const Ops&) const { const int part = row >> 5, k1 = k1base + (row & 31);
    *(u32x4*)(TBb + ((size_t)(k1 * 2 + part) * 4 * N2 + s2) * 128 + (col & 127)) = v; } };
struct EpiFFT3 { bf16_t* Ob; const bf16_t* Gb; int k2base, N1; static constexpr bool STAGED = true;
  template <int MI, int NI> __device__ __forceinline__ void pre(f32x16 (&acc)[MI][NI], int rb, int cb, int r32, int hi) const {}
  struct Ops { u32x4 g; };
  __device__ __forceinline__ Ops load(int row, int col) const { const size_t t = (size_t)(k2base + row) * N1; return Ops{*(const u32x4*)(Gb + t * ZP_ + col)}; }
  __device__ __forceinline__ void fin(int row, int col, const u32x4 v, const Ops& o) const { const size_t t = (size_t)(k2base + row) * N1;
    *(u32x4*)(Ob + t * DMIX + col) = mul_silu8(v, o.g); } };
struct EpiSGU { bf16_t* Ob; const bf16_t* Ub; const bf16_t* Gb; const float* bias; static constexpr bool STAGED = true;
  template <int MI, int NI> __device__ __forceinline__ void pre(f32x16 (&acc)[MI][NI], int rb, int cb, int r32, int hi) const {
#pragma unroll
    for (int mi = 0; mi < MI; ++mi)
#pragma unroll
      for (int r = 0; r < 16; ++r) { const float bv = bias[rb + mi * 32 + crow(r, hi)];
#pragma unroll
        for (int ni = 0; ni < NI; ++ni) acc[mi][ni][r] += bv; }
  }
  struct Ops { u32x4 u, g; };
  __device__ __forceinline__ Ops load(int row, int col) const { return Ops{*(const u32x4*)(Ub + (size_t)row * ZP_ + col), *(const u32x4*)(Gb + (size_t)row * ZP_ + col)}; }
  __device__ __forceinline__ void fin(int row, int col, const u32x4 v, const Ops& o) const {
    const u32x4 u = o.u, g = o.g; u32x4 w;
#pragma unroll
    for (int e = 0; e < 4; ++e) { const float g0 = bf2f(g[e] & 0xffffu), g1 = bf2f(g[e] >> 16);
      w[e] = pk2(bf2f(v[e] & 0xffffu) * bf2f(u[e] & 0xffffu) * silu_f(g0), bf2f(v[e] >> 16) * bf2f(u[e] >> 16) * silu_f(g1)); }
    *(u32x4*)(Ob + (size_t)row * DMIX + col) = w; } };


template <class BRow, class Epi>
__device__ __forceinline__ void gemm_tile_dual(LAS char* lds, const bf16_t* __restrict__ A0, const bf16_t* __restrict__ A1, int lda, const BRow& br0, const BRow& br1, int K, const Epi& ep0, const Epi& ep1) {
  constexpr int MI = 2, NI = 1, BM = 64, AP = 144, BP = 320, BOFF = BM * AP, USZ = BOFF + 64 * BP, ACH = 2;
  static_assert(2 * USZ <= LDS_HALF, "dual tile LDS");
  const int tid = otid(), lane = tid & 63, wid = __builtin_amdgcn_readfirstlane(tid >> 6), wn = wid, r32 = lane & 31, hi = lane >> 5;
  u32x4 ra[2][ACH], rb[2][4];
  f32x16 acc[2][MI][NI];
#pragma unroll
  for (int d = 0; d < 2; ++d)
#pragma unroll
    for (int mi = 0; mi < MI; ++mi)
#pragma unroll
      for (int r = 0; r < 16; ++r) acc[d][mi][0][r] = 0.f;
#define GD_GLOAD(k0) do { _Pragma("unroll") for (int d = 0; d < 2; ++d) { const bf16_t* Ad = d ? A1 : A0; \
    _Pragma("unroll") for (int i = 0; i < ACH; ++i) { const int c = tid + 256 * i; ra[d][i] = *(const u32x4*)(Ad + (size_t)(c >> 3) * lda + (k0) + (c & 7) * 8); } \
    _Pragma("unroll") for (int i = 0; i < 4; ++i) { const int c = tid + 256 * i; rb[d][i] = *(const u32x4*)((d ? br1((k0) + (c >> 4)) : br0((k0) + (c >> 4))) + (c & 15) * 8); } } } while (0)
#define GD_SSTORE() do { _Pragma("unroll") for (int d = 0; d < 2; ++d) { \
    _Pragma("unroll") for (int i = 0; i < ACH; ++i) { const int c = tid + 256 * i; *(LAS u32x4*)(lds + d * USZ + (c >> 3) * AP + (c & 7) * 16) = ra[d][i]; } \
    _Pragma("unroll") for (int i = 0; i < 4; ++i) { const int c = tid + 256 * i; *(LAS u32x4*)(lds + d * USZ + BOFF + (c >> 4) * BP + (c & 15) * 16) = rb[d][i]; } } } while (0)
  GD_GLOAD(0); GD_SSTORE(); __syncthreads();
  const int nk = K >> 6;
  LAS char* abase = lds + r32 * AP + hi * 16;
  LAS char* bbase = lds + BOFF + (8 * hi + ((lane & 15) >> 2)) * BP + (wn * 32 + ((lane >> 4) & 1) * 16 + (lane & 3) * 4) * 2;
  for (int kt = 0; kt < nk; ++kt) {
    if (kt + 1 < nk) GD_GLOAD((kt + 1) * 64);
#pragma unroll
    for (int kk = 0; kk < 4; ++kk) {
#pragma unroll
      for (int d = 0; d < 2; ++d) {
        const bf16x8 a0 = *(LAS bf16x8*)(abase + d * USZ + kk * 32), a1 = *(LAS bf16x8*)(abase + d * USZ + 32 * AP + kk * 32);
        const s16x4 lo = tr16(bbase + d * USZ + kk * 16 * BP), h4 = tr16(bbase + d * USZ + (kk * 16 + 4) * BP);
        const bf16x8 bv = (bf16x8){lo[0], lo[1], lo[2], lo[3], h4[0], h4[1], h4[2], h4[3]};
        acc[d][0][0] = __builtin_amdgcn_mfma_f32_32x32x16_bf16(a0, bv, acc[d][0][0], 0, 0, 0);
        acc[d][1][0] = __builtin_amdgcn_mfma_f32_32x32x16_bf16(a1, bv, acc[d][1][0], 0, 0, 0);
      }
    }
    __syncthreads();
    if (kt + 1 < nk) { GD_SSTORE(); __syncthreads(); }
  }
#undef GD_GLOAD
#undef GD_SSTORE
  constexpr int SP = NI * 64 + 16, CPR = NI * 4, RPP = 64 / CPR, NP = MI * 32 / RPP;
  const int cb = wn * 32;
  typename Epi::Ops ops[2][NP];
#pragma unroll
  for (int ps = 0; ps < NP; ++ps) { ops[0][ps] = ep0.load(ps * RPP + lane / CPR, cb + (lane % CPR) * 8); ops[1][ps] = ep1.load(ps * RPP + lane / CPR, cb + (lane % CPR) * 8); }
  LAS char* st = lds + wid * (MI * 32 * SP);
#pragma unroll
  for (int d = 0; d < 2; ++d) {
    if (d == 0) ep0.pre(acc[0], 0, cb, r32, hi); else ep1.pre(acc[1], 0, cb, r32, hi);
#pragma unroll
    for (int mi = 0; mi < MI; ++mi)
#pragma unroll
      for (int r = 0; r < 16; ++r) *(LAS bf16_t*)(st + (mi * 32 + crow(r, hi)) * SP + r32 * 2) = (bf16_t)f2bf(acc[d][mi][0][r]);
    asm volatile("s_waitcnt lgkmcnt(0)" ::: "memory");
#pragma unroll
    for (int ps = 0; ps < NP; ++ps) { const int row = ps * RPP + lane / CPR, chk = lane % CPR;
      const u32x4 v = *(LAS u32x4*)(st + row * SP + chk * 16);
      if (d == 0) ep0.fin(row, cb + chk * 8, v, ops[0][ps]); else ep1.fin(row, cb + chk * 8, v, ops[1][ps]); }
    asm volatile("s_waitcnt lgkmcnt(0)" ::: "memory");
  }
  __syncthreads();
}

template <int D, bool PF, int NWV>
__device__ __forceinline__ void attn_unit(LAS char* lds, const bf16_t* Qw, size_t ldq, const bf16_t* Kp, size_t ldk, const bf16_t* Vp, size_t ldv, int nkeys, float c,
                                          const bf16_t* Gw, size_t ldg, bf16_t* Ow, size_t ldo) {
  constexpr int NTH = NWV * 64, ND = D / 16, NB = D / 32, KP = D * 2 + 16, VP = (D == 64 ? 192 : 320), V_OFF = 64 * KP, CH = 64 * (D / 8) / NTH, RCH = D / 8;
  constexpr int W_OFF = (V_OFF + 64 * VP) > NWV * 32 * (D * 2 + 16) ? (V_OFF + 64 * VP) : NWV * 32 * (D * 2 + 16);
  int tid_ = NWV == 8 ? (int)threadIdx.x : (int)(threadIdx.x & 255); asm volatile("" : "+v"(tid_));
  const int tid = tid_, lane = tid & 63, wid = __builtin_amdgcn_readfirstlane(tid >> 6), r32 = lane & 31, hi = lane >> 5;
  bf16x8 qr[ND];
#pragma unroll
  for (int d0 = 0; d0 < ND; ++d0) qr[d0] = *(const bf16x8*)(Qw + (size_t)r32 * ldq + d0 * 16 + hi * 8);
  f32x16 o[NB];
#pragma unroll
  for (int nb = 0; nb < NB; ++nb)
#pragma unroll
    for (int r = 0; r < 16; ++r) o[nb][r] = 0.f;
  float m = -1e30f, l = 0.f;
  u32x4 rk[CH], rv[CH];
  LAS float* wsf = (LAS float*)(lds + W_OFF + wid * 128);
#define AT_GLOAD(t) do { _Pragma("unroll") for (int i = 0; i < CH; ++i) { const int cc = tid + NTH * i; const size_t row = (size_t)(t) * 64 + cc / RCH; const int ch = cc % RCH; \
      rk[i] = *(const u32x4*)(Kp + row * ldk + ch * 8); rv[i] = *(const u32x4*)(Vp + row * ldv + ch * 8); } } while (0)
#define AT_SSTORE() do { _Pragma("unroll") for (int i = 0; i < CH; ++i) { const int cc = tid + NTH * i; const int row = cc / RCH, ch = cc % RCH; \
      *(LAS u32x4*)(lds + row * KP + ch * 16) = rk[i]; *(LAS u32x4*)(lds + V_OFF + row * VP + ch * 16) = rv[i]; } } while (0)
  const int nt = nkeys >> 6;
  AT_GLOAD(0); AT_SSTORE(); __syncthreads();
  LAS char* kb = lds + r32 * KP + hi * 16;
  LAS char* vb = lds + V_OFF + (4 * hi + ((lane & 15) >> 2)) * VP + (((lane >> 4) & 1) * 16 + (lane & 3) * 4) * 2;
  for (int t = 0; t < nt; ++t) {
    if (PF && t + 1 < nt) AT_GLOAD(t + 1);
    f32x16 p0, p1;
#pragma unroll
    for (int r = 0; r < 16; ++r) { p0[r] = 0.f; p1[r] = 0.f; }
#pragma unroll
    for (int d0 = 0; d0 < ND; ++d0) {
      const bf16x8 k0 = *(LAS bf16x8*)(kb + d0 * 32), k1 = *(LAS bf16x8*)(kb + 32 * KP + d0 * 32);
      p0 = __builtin_amdgcn_mfma_f32_32x32x16_bf16(k0, qr[d0], p0, 0, 0, 0);
      p1 = __builtin_amdgcn_mfma_f32_32x32x16_bf16(k1, qr[d0], p1, 0, 0, 0);
    }
    float mx = p0[0];
#pragma unroll
    for (int r = 1; r < 16; ++r) mx = fmaxf(mx, p0[r]);
#pragma unroll
    for (int r = 0; r < 16; ++r) mx = fmaxf(mx, p1[r]);
    mx = fmaxf(mx, __shfl_xor(mx, 32));
    if (__any(mx > m)) {
      const float mn = fmaxf(m, mx), alpha = __builtin_amdgcn_exp2f((m - mn) * c); m = mn; l *= alpha;
      if (hi == 0) wsf[r32] = alpha;
      asm volatile("s_waitcnt lgkmcnt(0)" ::: "memory");
#pragma unroll
      for (int g = 0; g < 4; ++g) { const f32x4 a4 = *(LAS f32x4*)(wsf + 8 * g + 4 * hi);
#pragma unroll
        for (int nb = 0; nb < NB; ++nb)
#pragma unroll
          for (int i = 0; i < 4; ++i) o[nb][4 * g + i] *= a4[i]; }
      asm volatile("s_waitcnt lgkmcnt(0)" ::: "memory");
    }
    const float mc = m * c;
    float rs = 0.f;
#pragma unroll
    for (int r = 0; r < 16; ++r) { p0[r] = __builtin_amdgcn_exp2f(p0[r] * c - mc); rs += p0[r]; }
#pragma unroll
    for (int r = 0; r < 16; ++r) { p1[r] = __builtin_amdgcn_exp2f(p1[r] * c - mc); rs += p1[r]; }
    l += rs;
    bf16x8 pa[4];
#pragma unroll
    for (int s = 0; s < 2; ++s) {
      u32x4 w0, w1;
      w0[0] = pk2(p0[8 * s + 0], p0[8 * s + 1]); w0[1] = pk2(p0[8 * s + 2], p0[8 * s + 3]); w0[2] = pk2(p0[8 * s + 4], p0[8 * s + 5]); w0[3] = pk2(p0[8 * s + 6], p0[8 * s + 7]);
      w1[0] = pk2(p1[8 * s + 0], p1[8 * s + 1]); w1[1] = pk2(p1[8 * s + 2], p1[8 * s + 3]); w1[2] = pk2(p1[8 * s + 4], p1[8 * s + 5]); w1[3] = pk2(p1[8 * s + 6], p1[8 * s + 7]);
      pa[s] = __builtin_bit_cast(bf16x8, w0); pa[2 + s] = __builtin_bit_cast(bf16x8, w1);
    }
#pragma unroll
    for (int nb = 0; nb < NB; ++nb)
#pragma unroll
      for (int s = 0; s < 4; ++s) {
        const s16x4 lo = tr16(vb + (16 * s) * VP + nb * 64), h4 = tr16(vb + (16 * s + 8) * VP + nb * 64);
        const bf16x8 vf = (bf16x8){lo[0], lo[1], lo[2], lo[3], h4[0], h4[1], h4[2], h4[3]};
        o[nb] = __builtin_amdgcn_mfma_f32_32x32x16_bf16(pa[s], vf, o[nb], 0, 0, 0);
      }
    __syncthreads();
    if (t + 1 < nt) { if (!PF) AT_GLOAD(t + 1); AT_SSTORE(); __syncthreads(); }
  }
#undef AT_GLOAD
#undef AT_SSTORE
  l += __shfl_xor(l, 32);
  if (hi == 0) wsf[r32] = 1.0f / l;
  asm volatile("s_waitcnt lgkmcnt(0)" ::: "memory");
  constexpr int SP = D * 2 + 16, CPR = D / 8, RPP = 64 / CPR, NP = 32 / RPP;
  u32x4 gts[NP];
#pragma unroll
  for (int ps = 0; ps < NP; ++ps) gts[ps] = *(const u32x4*)(Gw + (size_t)(ps * RPP + lane / CPR) * ldg + (lane % CPR) * 8);
  LAS char* st = lds + wid * (32 * SP);
#pragma unroll
  for (int g = 0; g < 4; ++g) { const f32x4 a4 = *(LAS f32x4*)(wsf + 8 * g + 4 * hi);
#pragma unroll
    for (int i = 0; i < 4; ++i)
#pragma unroll
      for (int nb = 0; nb < NB; ++nb) *(LAS bf16_t*)(st + (8 * g + 4 * hi + i) * SP + (nb * 32 + r32) * 2) = (bf16_t)f2bf(o[nb][4 * g + i] * a4[i]); }
  asm volatile("s_waitcnt lgkmcnt(0)" ::: "memory");
#pragma unroll
  for (int ps = 0; ps < NP; ++ps) { const int row = ps * RPP + lane / CPR, chk = lane % CPR;
    const u32x4 v = *(LAS u32x4*)(st + row * SP + chk * 16);
    *(u32x4*)(Ow + (size_t)row * ldo + chk * 8) = mul_silu8(v, gts[ps]); }
  __syncthreads();
}

__device__ __forceinline__ void row_norm_bf16(const float* x, const float* g, bf16_t* out, int lane) {
  f32x4 v[4]; float ss = 0.f;
#pragma unroll
  for (int i = 0; i < 4; ++i) { v[i] = *(const f32x4*)(x + lane * 4 + i * 256); ss += v[i][0] * v[i][0] + v[i][1] * v[i][1] + v[i][2] * v[i][2] + v[i][3] * v[i][3]; }
  ss = wave_sum(ss); const float rs = rsqrtf(ss * (1.0f / 1024.0f) + EPS);
#pragma unroll
  for (int i = 0; i < 4; ++i) { f32x4 gg = {1.f, 1.f, 1.f, 1.f}; if (g) gg = *(const f32x4*)(g + lane * 4 + i * 256);
    u32x2 w; w[0] = pk2(v[i][0] * rs * gg[0], v[i][1] * rs * gg[1]); w[1] = pk2(v[i][2] * rs * gg[2], v[i][3] * rs * gg[3]);
    *(u32x2*)(out + lane * 4 + i * 256) = w; }
}

__device__ __forceinline__ void unpack8(const u32x4 w, float* v) {
#pragma unroll
  for (int i = 0; i < 4; ++i) { v[2 * i] = bf2f(w[i] & 0xffffu); v[2 * i + 1] = bf2f(w[i] >> 16); }
}
__device__ __forceinline__ u32x4 pack8(const float* v) { u32x4 w;
#pragma unroll
  for (int i = 0; i < 4; ++i) w[i] = pk2(v[2 * i], v[2 * i + 1]); return w; }

__device__ __forceinline__ void head_norm_rope(bf16_t* ptr, const float* gain  , const float* rope  , int lane, float osc) {
  const u32x4 w = *(const u32x4*)ptr; float v[8]; unpack8(w, v);
  float ss = 0.f;
#pragma unroll
  for (int e = 0; e < 8; ++e) ss += v[e] * v[e];
  ss += __shfl_xor(ss, 1); ss += __shfl_xor(ss, 2); ss += __shfl_xor(ss, 4);
  const float rs = rsqrtf(ss * (1.0f / 64.0f) + EPS);
  const int sub = lane & 7, a = sub >> 2, isx2 = (sub >> 1) & 1, p0 = (sub & 1) * 8;
  float o[8];
#pragma unroll
  for (int e = 0; e < 8; ++e) v[e] = v[e] * rs * gain[sub * 8 + e];
#pragma unroll
  for (int e = 0; e < 8; ++e) { const float pv = __shfl_xor(v[e], 2); const float co = rope[a * 16 + p0 + e], si = rope[32 + a * 16 + p0 + e];
    o[e] = (v[e] * co + (isx2 ? pv : -pv) * si) * osc; }
  *(u32x4*)ptr = pack8(o);
}

struct Ctx {
  const float* x_prompt; const float* x_sample; const float* mem_prompt; const float* mem_sample; const float* pre_g; const float* w_in; const float* q_g; const float* k_g;
  const float* w_f; const float* v_g; const float* w_s; const float* b_s; const float* mem_g; const float* w_mkv; const float* w_out; const float* post_g;
  float* out; char* ws;
  __device__ __forceinline__ bf16_t* XB() const { return (bf16_t*)(ws + OFF_XB); }
  __device__ __forceinline__ bf16_t* O() const { return (bf16_t*)(ws + OFF_O); }
  __device__ __forceinline__ bf16_t* Z() const { return (bf16_t*)(ws + OFF_ZY); }
  __device__ __forceinline__ bf16_t* ZB() const { return (bf16_t*)out; }
  __device__ __forceinline__ float* Y() const { return (float*)(ws + OFF_ZY); }
  __device__ __forceinline__ bf16_t* TB() const { return (bf16_t*)(ws + OFF_TB); }
  __device__ __forceinline__ bf16_t* WIN() const { return (bf16_t*)(ws + OFF_WIN); }
  __device__ __forceinline__ bf16_t* WFA() const { return (bf16_t*)(ws + OFF_WFA); }
  __device__ __forceinline__ bf16_t* WOUT() const { return (bf16_t*)(ws + OFF_WOUT); }
  __device__ __forceinline__ bf16_t* WMKV() const { return (bf16_t*)(ws + OFF_WMKV); }
  __device__ __forceinline__ bf16_t* MEMN() const { return (bf16_t*)(ws + OFF_MEMN); }
  __device__ __forceinline__ bf16_t* MKV() const { return (bf16_t*)(ws + OFF_MKV); }
  __device__ __forceinline__ bf16_t* WCS() const { return (bf16_t*)(ws + OFF_WCS); }
  __device__ __forceinline__ bf16_t* WSB() const { return (bf16_t*)(ws + OFF_WSB); }
  __device__ __forceinline__ bf16_t* A1_64() const { return (bf16_t*)(ws + OFF_A1_64); }
  __device__ __forceinline__ bf16_t* A1_128() const { return (bf16_t*)(ws + OFF_A1_128); }
  __device__ __forceinline__ bf16_t* A3_64() const { return (bf16_t*)(ws + OFF_A3_64); }
  __device__ __forceinline__ bf16_t* A3_128() const { return (bf16_t*)(ws + OFF_A3_128); }
  __device__ __forceinline__ float* TW8192() const { return (float*)(ws + OFF_TW8192); }
  __device__ __forceinline__ float* TW2048() const { return (float*)(ws + OFF_TW2048); }
  __device__ __forceinline__ float* ROPE() const { return (float*)(ws + OFF_ROPE); }
};

__device__ __forceinline__ bf16_t* zp(const Ctx& c, int si, size_t row, int col) { const int blk = col >> 7;
  bf16_t* base = blk < ZBLKA ? c.Z() : c.ZB(); return base + ((size_t)(blk < ZBLKA ? blk : blk - ZBLKA) * ZROWS + (size_t)si * CH_TOK + row) * 128 + (col & 127); }

__device__ __forceinline__ void phase_prep_a(const Ctx& c, LAS char* lds) {
  const int tid = otid(), lane = tid & 63, wid = tid >> 6;
  const int gw = vblk() * 4 + wid, nw = vgrid() * 4;
  const size_t gt = (size_t)vblk() * 256 + tid, gs = (size_t)vgrid() * 256;
  LAS float* ctab = (LAS float*)(lds + LDS_TAB); LAS float* stab = ctab + 128;
  for (int row = gw; row < NTOK; row += 2 * nw) {
    const int row2 = row + nw < NTOK ? row + nw : row;
    const float* x = row < NPROMPT_TOK ? c.x_prompt + (size_t)row * DM : c.x_sample + (size_t)(row - NPROMPT_TOK) * DM;
    const float* x2 = row2 < NPROMPT_TOK ? c.x_prompt + (size_t)row2 * DM : c.x_sample + (size_t)(row2 - NPROMPT_TOK) * DM;
    f32x4 v[2][4]; float ss0 = 0.f, ss1 = 0.f;
#pragma unroll
    for (int i = 0; i < 4; ++i) { v[0][i] = *(const f32x4*)(x + lane * 4 + i * 256); v[1][i] = *(const f32x4*)(x2 + lane * 4 + i * 256); }
#pragma unroll
    for (int i = 0; i < 4; ++i) { ss0 += v[0][i][0] * v[0][i][0] + v[0][i][1] * v[0][i][1] + v[0][i][2] * v[0][i][2] + v[0][i][3] * v[0][i][3];
      ss1 += v[1][i][0] * v[1][i][0] + v[1][i][1] * v[1][i][1] + v[1][i][2] * v[1][i][2] + v[1][i][3] * v[1][i][3]; }
    ss0 = wave_sum(ss0); ss1 = wave_sum(ss1);
    const float ms0 = ss0 * (1.0f / 1024.0f) + EPS, ms1 = ss1 * (1.0f / 1024.0f) + EPS; const float rs0 = rsqrtf(ms0), rs1 = rsqrtf(ms1);
    if (lane == 0) { float* rsa = (float*)(c.ws + OFF_RS2); rsa[row] = ms0 * rs0; rsa[row2] = ms1 * rs1; }
#pragma unroll
    for (int i = 0; i < 4; ++i) { const f32x4 gg = {1.f, 1.f, 1.f, 1.f};
      u32x2 w; w[0] = pk2(v[0][i][0] * rs0 * gg[0], v[0][i][1] * rs0 * gg[1]); w[1] = pk2(v[0][i][2] * rs0 * gg[2], v[0][i][3] * rs0 * gg[3]);
      *(u32x2*)(c.XB() + (size_t)row * DM + lane * 4 + i * 256) = w;
      u32x2 w2; w2[0] = pk2(v[1][i][0] * rs1 * gg[0], v[1][i][1] * rs1 * gg[1]); w2[1] = pk2(v[1][i][2] * rs1 * gg[2], v[1][i][3] * rs1 * gg[3]);
      *(u32x2*)(c.XB() + (size_t)row2 * DM + lane * 4 + i * 256) = w2; }
  }
  for (int row = gw; row < NMEMROWS; row += nw) {
    const float* x = row < 512 ? c.mem_prompt + (size_t)row * DM : c.mem_sample + (size_t)(row - 512) * DM;
    row_norm_bf16(x, nullptr, c.MEMN() + (size_t)row * DM, lane);
  }
  { LAS float* scr = (LAS float*)(vlds(lds) + wid * 8448);
    const int n_in = 2 * 16 * 152, n_out = 2 * 32 * 32, n_mkv = 2 * 16 * 32;
    for (int it = gw; it < n_in + n_out + n_mkv; it += nw) {
      const float* W; int N, k0, n0, Kd; bf16_t* WT; bool plain = false; int l; const float* kgain = nullptr;
      if (it < n_in) { l = it / (16 * 152); const int r = it % (16 * 152); k0 = (r / 152) * 64; n0 = (r % 152) * 32; W = c.w_in + (size_t)l * 1024 * 4864; N = 4864; Kd = 1024; kgain = c.pre_g + l * 1024;
        plain = (n0 >= 1280 && n0 < 1792); const int nr = n0 < 1280 ? n0 : n0 + 512; WT = c.WIN() + ((size_t)l * NZ + nr) * 1024; }
      else if (it < n_in + n_out) { const int r0 = it - n_in; l = r0 / 1024; const int r = r0 % 1024; k0 = (r / 32) * 64; n0 = (r % 32) * 32; W = c.w_out + (size_t)l * 2048 * 1024; N = 1024; Kd = 2048; WT = c.WOUT() + ((size_t)l * 1024 + n0) * 2048; }
      else { const int r0 = it - n_in - n_out; l = r0 / 512; const int r = r0 % 512; k0 = (r / 32) * 64; n0 = (r % 32) * 32; W = c.w_mkv + (size_t)l * 1024 * 1024; N = 1024; Kd = 1024; WT = c.WMKV() + ((size_t)l * 1024 + n0) * 1024; kgain = c.mem_g + l * 1024; }
      if (plain) {
#pragma unroll 8
        for (int i = 0; i < 32; ++i) { const int kk = 2 * i + (lane >> 5); c.WFA()[((size_t)l * 1024 + k0 + kk) * 512 + (n0 - 1280) + (lane & 31)] = (bf16_t)f2bf(W[(size_t)(k0 + kk) * N + n0 + (lane & 31)] * kgain[k0 + kk]); }
      } else {
#pragma unroll 8
        for (int i = 0; i < 32; ++i) { const int kk = 2 * i + (lane >> 5); scr[kk * 33 + (lane & 31)] = W[(size_t)(k0 + kk) * N + n0 + (lane & 31)]; }
        asm volatile("s_waitcnt lgkmcnt(0)" ::: "memory");
        const int cch = lane & 7;
#pragma unroll
        for (int j = 0; j < 4; ++j) { const int n = (lane >> 3) + 8 * j; const LAS float* sp = scr + (8 * cch) * 33 + n;
          float gk[8];
#pragma unroll
          for (int e = 0; e < 8; ++e) gk[e] = kgain ? kgain[k0 + 8 * cch + e] : 1.0f;
          u32x4 o; o[0] = pk2(sp[0] * gk[0], sp[33] * gk[1]); o[1] = pk2(sp[2 * 33] * gk[2], sp[3 * 33] * gk[3]); o[2] = pk2(sp[4 * 33] * gk[4], sp[5 * 33] * gk[5]); o[3] = pk2(sp[6 * 33] * gk[6], sp[7 * 33] * gk[7]);
          *(u32x4*)(WT + (size_t)n * Kd + k0 + 8 * cch) = o; }
        asm volatile("s_waitcnt lgkmcnt(0)" ::: "memory");
      }
    }
  }
  for (size_t i = gt; i < (size_t)32768; i += gs) { const f32x4 v = *(const f32x4*)(c.w_s + i * 4); u32x2 w; w[0] = pk2(v[0], v[1]); w[1] = pk2(v[2], v[3]); *(u32x2*)(c.WSB() + i * 4) = w; }
  for (size_t i = gt; i < (size_t)262144; i += gs) {
    const int n = (int)(i & 255), cp = (int)((i >> 8) & 127), lg = (int)(i >> 15); const int d = n & 127; const bool is_sin = n >= 128;
    const float* wf = c.w_f + (size_t)lg * 16384 + d; float s = 0.f;
#pragma unroll 16
    for (int kc = 0; kc < 128; ++kc) { const int j = (kc * cp) & 127; s += (is_sin ? stab[j] : ctab[j]) * wf[kc * 128]; }
    c.WCS()[i] = (bf16_t)f2bf(s * 0.08838834764831845f);
  }
  for (size_t i = gt; i < (size_t)(4096 + 16384); i += gs) {
    const bool big = i >= 4096; const int idx = big ? (int)i - 4096 : (int)i; const int N1 = big ? 64 : 32, W = 2 * N1;
    const int rho = idx / W, kap = idx % W; const int part = (rho & 63) >> 5, k1 = (rho >> 6) * 32 + (rho & 31), pin = kap / N1, s1 = kap % N1;
    float sn, cs; sincospif(2.0f * (float)((k1 * s1) % N1) / (float)N1, &sn, &cs);
    const float sc = rsqrtf((float)N1); float v = (part == pin) ? cs : -sn; if (part == 1 && pin == 1) v = -cs;
    (big ? c.A1_128() : c.A1_64())[idx] = (bf16_t)f2bf(v * sc);
  }
  for (size_t i = gt; i < (size_t)(8192 + 32768); i += gs) {
    const bool big = i >= 8192; const int idx = big ? (int)i - 8192 : (int)i; const int N2 = big ? 128 : 64, W = 2 * N2;
    const int k2 = idx / W, kap = idx % W, pin = kap / N2, s2 = kap % N2;
    float sn, cs; sincospif(2.0f * (float)((k2 * s2) % N2) / (float)N2, &sn, &cs);
    (big ? c.A3_128() : c.A3_64())[idx] = (bf16_t)f2bf((pin ? sn : cs) * rsqrtf((float)N2));
  }
  for (size_t i = gt; i < (size_t)(8192 + 2048); i += gs) {
    const bool small = i >= 8192; const int j = small ? (int)i - 8192 : (int)i; const int S = small ? 2048 : 8192;
    float sn, cs; sincospif(2.0f * (float)j / (float)S, &sn, &cs);
    float* d = (small ? c.TW2048() : c.TW8192()) + 2 * j; d[0] = cs; d[1] = sn;
  }
  for (size_t i = gt; i < (size_t)8192 * 32; i += gs) {
    const int t = (int)(i >> 5), ap = (int)(i & 31), a = ap >> 4, p = ap & 15;
    const float inv = powf(10000.0f, -(float)p / 16.0f); const float pos = (float)(a == 0 ? (t >> 6) : (t & 63)); const float ang = pos * inv;
    float sn, cs; sincosf(ang, &sn, &cs);
    c.ROPE()[(size_t)t * 64 + ap] = cs; c.ROPE()[(size_t)t * 64 + 32 + ap] = sn;
  }
}

__device__ __forceinline__ void phase_prep_b(const Ctx& c, LAS char* lds) {
  { pg8::Gemm g{c.MEMN(), c.WMKV(), NMEMROWS, 2048, DM}; pg8::StaticOrder S; S.init(NMEMROWS, 2048, (int)gridDim.x, (int)blockIdx.x);
    pg8::EpiBf16 E{c.MKV(), 2048};
    pg8::gemm_phase<pg8::EpiBf16, pg8::StaticOrder, true, true>((PG8_LAS unsigned char*)lds, g, S, E); }
  LAS char* vl = vlds(lds);
  for (int u = vblk(); u < 128; u += vgrid()) {
    const int nt = u & 1, mt = (u >> 1) & 7, g = (u >> 4) & 3, l = u >> 6;
    BRowPlain br{c.WCS() + ((size_t)(l * 4 + g) * 128) * 256 + nt * 128, 256};
    EpiStoreBf16T ep{c.WIN() + ((size_t)l * NZ + ZP + nt * 512 + g * 128) * 1024 + mt * 128, 1024};
    gemm_tile<2, 2, 2, 2, false>(vl, c.WFA() + ((size_t)l * 1024 + mt * 128) * 512 + g * 128, 512, br, 128, ep);
  }
}

__device__ __forceinline__ void phase_g1(const Ctx& c, LAS char* lds, int l, int seg0, int nseg) {
  const size_t tok0 = (size_t)seg0 * CH_TOK; const int MG = nseg * CH_TOK;
  const bf16_t* A = c.XB() + tok0 * DM; const bf16_t* Bt = c.WIN() + (size_t)l * NZ * 1024;
  pg8::StaticOrder S; S.init(MG, NZ, (int)gridDim.x, (int)blockIdx.x);
  pg8::Gemm g{A, Bt, MG, NZ, DM}; pg8::EpiBf16Blk E{c.Z(), c.ZB(), (size_t)ZROWS};
  pg8::gemm_phase<pg8::EpiBf16Blk, pg8::StaticOrder, true, true>((PG8_LAS unsigned char*)lds, g, S, E);
}

__device__ __forceinline__ void phase_norm_fft1(const Ctx& c, LAS char* lds, int l, int ch, int si) {
  bf16_t* const TBs = c.TB() + (size_t)si * CH_TOK * 1024;
  const int S = ch == 0 ? 8192 : 2048, N1 = ch == 0 ? 64 : 32, N2 = ch == 0 ? 128 : 64, n1log = ch == 0 ? 6 : 5, MT = ch == 0 ? 2 : 1;
  const bf16_t* A1 = ch == 0 ? c.A1_128() : c.A1_64(); const float* tw = ch == 0 ? c.TW8192() : c.TW2048();
  LAS char* vl = vlds(lds);
  for (int u = vblk(); u < 2048; u += 2 * vgrid()) {
    const int u2 = u + vgrid(); const bool two = u2 < 2048;
    int v = u; const int nt = v & 3; v >>= 2; const int mt = v % MT; v /= MT; const int s2 = v % N2; const int b = v / N2;
    BRowFFT1 br{zp(c, si, (size_t)b * S + s2, ZP + nt * 128), (size_t)N2 * ZP_, (size_t)4 * ZROWS * 128, N1 - 1, n1log};
    EpiFFT1 ep{TBs + (size_t)b * N1 * 2 * N2 * 512 + (size_t)nt * N2 * 128, tw, mt * 32, s2, N2};
    if (two) {
      int w = u2; const int nt2 = w & 3; w >>= 2; const int mt2 = w % MT; w /= MT; const int s22 = w % N2; const int b2 = w / N2;
      BRowFFT1 br2{zp(c, si, (size_t)b2 * S + s22, ZP + nt2 * 128), (size_t)N2 * ZP_, (size_t)4 * ZROWS * 128, N1 - 1, n1log};
      EpiFFT1 ep2{TBs + (size_t)b2 * N1 * 2 * N2 * 512 + (size_t)nt2 * N2 * 128, tw, mt2 * 32, s22, N2};
      gemm_tile_dual(vl, A1 + (size_t)mt * 64 * 2 * N1, A1 + (size_t)mt2 * 64 * 2 * N1, 2 * N1, br, br2, 2 * N1, ep, ep2);
    } else gemm_tile<1, 4, 2, 1, false>(vl, A1 + (size_t)mt * 64 * 2 * N1, 2 * N1, br, 2 * N1, ep);
  }
  const int tid = otid(), lane = tid & 63, wid = tid >> 6;
  const float* qg = c.q_g + l * 64; const float* kg = c.k_g + l * 64; const float* vg = c.v_g + l * 512;
  for (int task = vblk() * 4 + wid; task < CH_TOK / 4; task += vgrid() * 4) {
    const int t0 = task * 4;
    { const int tok = t0 + (lane >> 4); const int pos = tok & (S - 1);
      head_norm_rope(zp(c, si, tok, ZK + (lane & 15) * 8), kg, c.ROPE() + (size_t)pos * 64, lane, 1.0f); }
  }
}

__device__ __forceinline__ void phase_mix(const Ctx& c, LAS char* lds, int l, int ch, int si) {
  bf16_t* const TBs = c.TB() + (size_t)si * CH_TOK * 1024;
  const int S = ch == 0 ? 8192 : 2048, N1 = ch == 0 ? 64 : 32, N2 = ch == 0 ? 128 : 64, MT = ch == 0 ? 2 : 1, slog = ch == 0 ? 13 : 11, n2log = ch == 0 ? 7 : 6;
  const bf16_t* A3 = ch == 0 ? c.A3_128() : c.A3_64();
  const size_t tok0 = (size_t)ch * CH_TOK;
  const int wid = otid() >> 6;
  const int nqb = S / 128;
  const int n_att = 1024, n_mem = 512, n_sgu = 512, n_fft = 1024;
  { const int nqb8 = S / 256;
    for (int u = blockIdx.x; u < 512; u += gridDim.x) {
      const int hq = u & 3; int v = u >> 2; const int qb = v % nqb8; v /= nqb8; const int kvh = v & 1, b = v >> 1; const int h = kvh * 4 + hq;
      const size_t rq = (size_t)b * S + (size_t)qb * 256;
      attn_body::attn_unit<8>((const attn_body::bf16*)(zp(c, si, rq, ZQ + h * 64)), (const attn_body::bf16*)(zp(c, si, (size_t)b * S, ZK + kvh * 64)),
                              (const attn_body::bf16*)(zp(c, si, (size_t)b * S, ZV + kvh * 64)), (const attn_body::bf16*)(zp(c, si, rq, ZAG + h * 64)),
                              (attn_body::bf16*)(c.O() + (tok0 + rq) * DMIX + h * 64), S / 64, (char*)lds, c.q_g + l * 64, c.ROPE() + (size_t)(qb * 256) * 64);
    } }
  { const int wid8 = __builtin_amdgcn_readfirstlane((int)(threadIdx.x >> 6));
    for (int u = blockIdx.x; u < 256; u += gridDim.x) {
      const int head = u & 3, qb = u >> 2;
      const size_t rq = (size_t)qb * 256 + wid8 * 32; const size_t tg = tok0 + (size_t)qb * 256;
      const int mb = tg < NPROMPT_TOK ? (int)(tg >> 13) : 2 + (int)((tg - NPROMPT_TOK) >> 11);
      const bf16_t* kp = c.MKV() + ((size_t)mb * 256) * 2048 + l * 1024 + head * 128;
      attn_unit<128, true, 8>(lds, zp(c, si, rq, ZMQ + head * 128), ZP_, kp, 2048, kp + 512, 2048, 256, 0.08838834764831845f * 1.4426950408889634f,
                              zp(c, si, rq, ZMG + head * 128), ZP_, c.O() + (tok0 + rq) * DMIX + 1536 + head * 128, DMIX);
    } }
  LAS char* vl = vlds(lds);
  for (int u = vblk() + n_att + n_mem; u < n_att + n_mem + n_sgu + n_fft; u += vgrid()) {
    if (u < n_att + n_mem + n_sgu) {
      const int v = u - n_att - n_mem; const int head = v & 3, ck = v >> 2; const size_t r0 = (size_t)ck * 128;
      BRowPlain br{zp(c, si, r0, ZSV + head * 128), ZP_};
      EpiSGU ep{c.O() + (tok0 + r0) * DMIX + 1024 + head * 128, zp(c, si, r0, ZSU + head * 128), zp(c, si, r0, ZSG + head * 128), c.b_s + (l * 4 + head) * 128};
      gemm_tile<2, 2, 2, 2, false>(vl, c.WSB() + (size_t)(l * 4 + head) * 16384, 128, br, 128, ep, BXSguNorm{c.v_g + (l * 4 + head) * 128});
    } else {
      int v = u - n_att - n_mem - n_sgu; const int nt = v & 3; v >>= 2; const int mt = v % MT; v /= MT; const int k1 = v % N1; const int b = v / N1;
      BRowFFT1 br{TBs + ((size_t)(b * N1 + k1) * 2 * N2) * 512 + (size_t)nt * N2 * 128, 128, (size_t)4 * N2 * 128, N2 - 1, n2log};
      const size_t tl = ((size_t)b << slog) + k1;
      EpiFFT3 ep{c.O() + (tok0 + tl) * DMIX + 512 + nt * 128, zp(c, si, tl, ZFG + nt * 128), mt * 64, N1};
      const int u2 = u + vgrid();
      if (u2 < n_att + n_mem + n_sgu + n_fft) {
        int w = u2 - n_att - n_mem - n_sgu; const int nt2 = w & 3; w >>= 2; const int mt2 = w % MT; w /= MT; const int k12 = w % N1; const int b2 = w / N1;
        BRowFFT1 br2{TBs + ((size_t)(b2 * N1 + k12) * 2 * N2) * 512 + (size_t)nt2 * N2 * 128, 128, (size_t)4 * N2 * 128, N2 - 1, n2log};
        const size_t tl2 = ((size_t)b2 << slog) + k12;
        EpiFFT3 ep2{c.O() + (tok0 + tl2) * DMIX + 512 + nt2 * 128, zp(c, si, tl2, ZFG + nt2 * 128), mt2 * 64, N1};
        gemm_tile_dual(vl, A3 + (size_t)mt * 64 * 2 * N2, A3 + (size_t)mt2 * 64 * 2 * N2, 2 * N2, br, br2, 2 * N2, ep, ep2);
        u += vgrid();
      } else gemm_tile<1, 4, 2, 1, false>(vl, A3 + (size_t)mt * 64 * 2 * N2, 2 * N2, br, 2 * N2, ep);
    }
  }
}

__device__ __forceinline__ void phase_g2(const Ctx& c, LAS char* lds, int l) {
  pg8::Gemm g{c.O(), c.WOUT() + (size_t)l * 1024 * 2048, NTOK, DM, DMIX}; pg8::StaticOrder S; S.init(NTOK, DM, (int)gridDim.x, (int)blockIdx.x);
  pg8::EpiBf16 E{(bf16_t*)c.Y(), DM};
  pg8::gemm_phase<pg8::EpiBf16, pg8::StaticOrder, true, true>((PG8_LAS unsigned char*)lds, g, S, E);
}

__device__ __forceinline__ void phase_d(const Ctx& c, int l) {
  const int tid = otid(), lane = tid & 63, wid = tid >> 6;
  const float* pg = c.post_g + l * DM;
  float* rs2a = (float*)(c.ws + OFF_RS2);
  const int nw = vgrid() * 4;
  for (int row0 = vblk() * 4 + wid; row0 < NTOK; row0 += 2 * nw) {
    int rows[2]; rows[0] = row0; rows[1] = row0 + nw < NTOK ? row0 + nw : row0;
    f32x4 v[2][4], xv[2][4];
#pragma unroll
    for (int k = 0; k < 2; ++k) { const int row = rows[k];
      const bf16_t* y = (const bf16_t*)c.Y() + (size_t)row * DM;
#pragma unroll
      for (int i = 0; i < 4; ++i) { const u32x2 yw = *(const u32x2*)(y + lane * 4 + i * 256); v[k][i] = (f32x4){bf2f(yw[0] & 0xffffu), bf2f(yw[0] >> 16), bf2f(yw[1] & 0xffffu), bf2f(yw[1] >> 16)}; }
      { const bf16_t* xb = c.XB() + (size_t)row * DM; const float sc = rs2a[row];
#pragma unroll
        for (int i = 0; i < 4; ++i) { const u32x2 xw = *(const u32x2*)(xb + lane * 4 + i * 256); xv[k][i] = (f32x4){bf2f(xw[0] & 0xffffu) * sc, bf2f(xw[0] >> 16) * sc, bf2f(xw[1] & 0xffffu) * sc, bf2f(xw[1] >> 16) * sc}; } } }
#pragma unroll
    for (int k = 0; k < 2; ++k) { const int row = rows[k];
      if (k == 1 && rows[1] == rows[0]) break;
      float ss = 0.f;
#pragma unroll
      for (int i = 0; i < 4; ++i) ss += v[k][i][0] * v[k][i][0] + v[k][i][1] * v[k][i][1] + v[k][i][2] * v[k][i][2] + v[k][i][3] * v[k][i][3];
      ss = wave_sum(ss); const float rs = rsqrtf(ss * (1.0f / 1024.0f) + EPS);
      float ss2 = 0.f;
#pragma unroll
      for (int i = 0; i < 4; ++i) { const f32x4 g = *(const f32x4*)(pg + lane * 4 + i * 256);
        v[k][i] = xv[k][i] + v[k][i] * rs * g; ss2 += v[k][i][0] * v[k][i][0] + v[k][i][1] * v[k][i][1] + v[k][i][2] * v[k][i][2] + v[k][i][3] * v[k][i][3];
        if (l == 1) *(f32x4*)(c.out + (size_t)row * DM + lane * 4 + i * 256) = v[k][i]; }
      if (l == 0) {
        ss2 = wave_sum(ss2); const float ms = ss2 * (1.0f / 1024.0f) + EPS; const float rs2 = rsqrtf(ms);
        if (lane == 0) rs2a[row] = ms * rs2;
#pragma unroll
        for (int i = 0; i < 4; ++i) {
          u32x2 w; w[0] = pk2(v[k][i][0] * rs2, v[k][i][1] * rs2); w[1] = pk2(v[k][i][2] * rs2, v[k][i][3] * rs2);
          *(u32x2*)(c.XB() + (size_t)row * DM + lane * 4 + i * 256) = w; }
      }
    }
  }
}

__global__ void __launch_bounds__(512, 2) mega(Params p) {
  extern __shared__ __attribute__((aligned(16))) unsigned char lds_dyn[];
  LAS char* lds = (LAS char*)lds_dyn;
  Ctx c;
  c.x_prompt = p.in[0]; c.x_sample = p.in[1]; c.mem_prompt = p.in[2]; c.mem_sample = p.in[3]; c.pre_g = p.in[4]; c.w_in = p.in[5]; c.q_g = p.in[6]; c.k_g = p.in[7];
  c.w_f = p.in[8]; c.v_g = p.in[9]; c.w_s = p.in[10]; c.b_s = p.in[11]; c.mem_g = p.in[12]; c.w_mkv = p.in[13]; c.w_out = p.in[14]; c.post_g = p.in[15];
  c.out = p.out; c.ws = p.ws; char* ws = p.ws;
  cg::grid_group grid = cg::this_grid();
  volatile LAS unsigned* xbw = (volatile LAS unsigned*)(lds + LDS_XB);
  if (threadIdx.x < 4) xbw[threadIdx.x] = 0u;
  __syncthreads();
  const XcdBarrier xb = xcd_barrier_post((unsigned*)(ws + OFF_BAR), xbw);
  if (p.phase_hi > 1000) grid.sync();
  if (p.phase_lo == 0) {
    if (threadIdx.x < 128) { float sn, cs; sincospif((float)threadIdx.x / 64.0f, &sn, &cs); LAS float* ctab = (LAS float*)(lds + LDS_TAB); ctab[threadIdx.x] = cs; ctab[128 + threadIdx.x] = sn; }
    __syncthreads();
  }
  for (int ph = p.phase_lo; ph < p.phase_hi; ++ph) {
    if (ph == 0) phase_prep_a(c, lds);
    else if (ph == 1) phase_prep_b(c, lds);
    else {
      const int q = ph - 2, l = q / 8, r = q % 8;
      if (r < 6) { const int g = r / 3, st = r % 3, seg0 = 3 * g, nseg = g == 0 ? 3 : 2;
        if (st == 0) phase_g1(c, lds, l, seg0, nseg);
        else if (st == 1) { for (int si = 0; si < nseg; ++si) phase_norm_fft1(c, lds, l, seg0 + si, si); }
        else { for (int si = 0; si < nseg; ++si) phase_mix(c, lds, l, seg0 + si, si); }
      } else if (r == 6) phase_g2(c, lds, l);
      else phase_d(c, l);
    }
    if (ph + 1 < p.phase_hi) xcd_barrier(xb);
  }
}

extern "C" void kernel_launch(void* const* d_in, const int* in_sizes, int n_in, void* d_out, int out_size, void* d_ws, size_t ws_size, hipStream_t stream) {
  static int grid_blocks = 0;
  if (!grid_blocks) {
    int dev = 0, cus = 0, per_cu = 0;
    (void)hipGetDevice(&dev);
    (void)hipDeviceGetAttribute(&cus, hipDeviceAttributeMultiprocessorCount, dev);
    (void)hipFuncSetAttribute((const void*)mega, hipFuncAttributeMaxDynamicSharedMemorySize, LDS_BYTES);
    (void)hipOccupancyMaxActiveBlocksPerMultiprocessor(&per_cu, mega, 512, LDS_BYTES);
    (void)hipGetLastError();
    grid_blocks = cus;
  }
  if (ws_size < WS_NEED) { fprintf(stderr, "workspace too small: %zu < %zu\n", ws_size, (size_t)WS_NEED); return; }
  Params p{};
  for (int i = 0; i < 16; ++i) p.in[i] = (const float*)d_in[i];
  p.out = (float*)d_out; p.ws = (char*)d_ws; p.phase_lo = 0; p.phase_hi = NPHASE;
  (void)hipMemsetAsync((char*)d_ws + OFF_BAR, 0, XCD_BAR_WORDS * 4, stream);
  void* args[] = {&p};
  hipError_t e = hipLaunchCooperativeKernel((void*)mega, dim3(grid_blocks), dim3(512), args, LDS_BYTES, stream);
  if (e != hipSuccess) fprintf(stderr, "cooperative launch failed: %s (grid %d)\n", hipGetErrorString(e), grid_blocks);
}
```
